# Optimizing an MI355X kernel written in HIP

```python
import jax
import jax.numpy as jnp
from jax import lax
import numpy as np


D_MODEL = 1024
BATCH = 8
SEQ = 4096
DEPTH = 4

GRID_W = 64
CTX_LEN = 256
NORM_EPS = 1e-6
N_MOD = 6

RW_HEADS = 6
RW_HEAD_DIM = 64
RW_WIDTH = RW_HEADS * RW_HEAD_DIM
RW_DECAY_RANK = 64
RW_A_RANK = 64
RW_GATE_RANK = 128
RW_GN_EPS = 64e-5

GLA_HEADS = 4
GLA_DK = 48
GLA_DV = 96
GLA_KW = GLA_HEADS * GLA_DK
GLA_VW = GLA_HEADS * GLA_DV
GLA_RANK = 16
GLA_TAU = 16.0
GLA_CHUNK = 64

FN_GROUPS = 4
FN_GROUP_DIM = 64
FN_WIDTH = FN_GROUPS * FN_GROUP_DIM

N_BRANCH = 3
N_EXPERTS = 16
EXPERT_HIDDEN = 2048
CAPACITY_FACTOR = 2

CONV_K = 3
CONV_CH = 3 * RW_WIDTH + 2 * GLA_KW + GLA_VW
IN_SPLITS = (RW_WIDTH, RW_WIDTH, RW_WIDTH,
             GLA_KW, GLA_KW, GLA_VW,
             2 * RW_DECAY_RANK, 2 * RW_A_RANK,
             2 * GLA_RANK,
             RW_GATE_RANK,
             GLA_VW,
             FN_WIDTH,
             N_BRANCH * D_MODEL)
N_SCAN_PARTS = 9
IN_COLS = sum(IN_SPLITS)

kernel_name = 'hybrid_rwkv7_gla_fnet_ecmoe_dit'


def _rmsnorm(x, w):
    x32 = x.astype(jnp.float32)
    y = x32 * lax.rsqrt(jnp.mean(x32 * x32, axis=-1, keepdims=True) + NORM_EPS)
    return (y * w.astype(jnp.float32)).astype(x.dtype)


def _heads(x, n):
    return x.reshape(*x.shape[:-1], x.shape[-1] // n, n)


def _to_col_major(x, rows):
    b, t = x.shape[:2]
    rest = x.shape[2:]
    return jnp.swapaxes(x.reshape(b, rows, t // rows, *rest), 1, 2).reshape(b, t, *rest)


def _from_col_major(x, rows):
    b, t = x.shape[:2]
    rest = x.shape[2:]
    return jnp.swapaxes(x.reshape(b, t // rows, rows, *rest), 1, 2).reshape(b, t, *rest)


def _short_conv(x, w, rows):
    b, t, ch = x.shape
    grid = x.reshape(b, rows, t // rows, ch)
    y = lax.conv_general_dilated(grid, w[:, :, None, :].astype(x.dtype), window_strides=(1, 1), padding='SAME',
                                 dimension_numbers=('NHWC', 'HWIO', 'NHWC'), feature_group_count=ch)
    return y.reshape(b, t, ch)


def _rwkv7_scan(r, decay, k, v, kk, bb, s0):
    def step(s, inp):
        r_t, w_t, k_t, v_t, kk_t, b_t = inp
        s = (s * w_t[:, :, None, :]
             - jnp.einsum('bhvk,bhk->bhv', s, kk_t)[..., None] * b_t[:, :, None, :]
             + v_t[..., None] * k_t[:, :, None, :])
        return s, jnp.einsum('bhvk,bhk->bhv', s, r_t)
    xs = tuple(jnp.moveaxis(t, 1, 0) for t in (r, decay, k, v, kk, bb))
    s_fin, out = lax.scan(step, s0, xs)
    return jnp.moveaxis(out, 0, 1), s_fin


def _gla_chunked(q, k, v, log_a, s0):
    b, t = q.shape[:2]
    n = t // GLA_CHUNK
    ch = lambda a: a.reshape(b, n, GLA_CHUNK, *a.shape[2:])
    qc, kc, vc, gc = ch(q), ch(k), ch(v), ch(log_a)
    g_cum = jnp.cumsum(gc, axis=2)
    g_last = g_cum[:, :, -1:]
    q_in = qc * jnp.exp(g_cum)
    k_in = kc * jnp.exp(-g_cum)
    k_tail = kc * jnp.exp(g_last - g_cum)
    mask = jnp.tril(jnp.ones((GLA_CHUNK, GLA_CHUNK), dtype=bool))
    att = jnp.where(mask, jnp.einsum('bnihk,bnjhk->bnhij', q_in, k_in), 0.0)
    o_intra = jnp.einsum('bnhij,bnjhv->bnihv', att, vc)
    kv = jnp.einsum('bnjhk,bnjhv->nbhkv', k_tail, vc)
    dec = jnp.swapaxes(jnp.exp(g_last[:, :, 0]), 0, 1)

    def step(s, inp):
        d_c, kv_c = inp
        return s * d_c[..., None] + kv_c, s
    s_fin, s_prev = lax.scan(step, s0, (dec, kv))
    o_inter = jnp.einsum('bnihk,nbhkv->bnihv', q_in, s_prev)
    return (o_intra + o_inter).reshape(b, t, *v.shape[2:]), s_fin


def _prefix_scan(scan_fn, ins_ctx, ins_lat, s0, reverse):
    flip = (lambda a: jnp.flip(a, axis=1)) if reverse else (lambda a: a)
    o_ctx, s_ctx = scan_fn(*[flip(a) for a in ins_ctx], s0)
    o_lat, _ = scan_fn(*[flip(a) for a in ins_lat], s_ctx)
    return flip(o_ctx), flip(o_lat)


def _rwkv_dir(r, k, v, wd, ad, w0, w_up, a0, a_up, k_k, k_a):
    w_log = -jax.nn.softplus(-(w0 + jnp.tanh(wd) @ w_up)) - 0.5
    decay = jnp.exp(-jnp.exp(w_log))
    a = jax.nn.sigmoid(a0 + ad @ a_up)
    kk = _heads(k * k_k, RW_HEAD_DIM)
    kk = kk / jnp.maximum(jnp.sqrt(jnp.sum(kk * kk, axis=-1, keepdims=True)), 1e-12)
    k_mod = k * (1.0 + (a - 1.0) * k_a)
    hd = lambda a_: _heads(a_, RW_HEAD_DIM)
    return (hd(r), hd(decay), hd(k_mod), hd(v), kk, kk * hd(a))


def _scan_branches(pc, pl, lp):
    b = pl[0].shape[0]
    s0_rw = jnp.zeros((b, RW_HEADS, RW_HEAD_DIM, RW_HEAD_DIM), jnp.float32)
    s0_gla = jnp.zeros((b, GLA_HEADS, GLA_DK, GLA_DV), jnp.float32)

    def rw_in(p, d):
        wd = p[6][..., d * RW_DECAY_RANK:(d + 1) * RW_DECAY_RANK]
        ad = p[7][..., d * RW_A_RANK:(d + 1) * RW_A_RANK]
        return _rwkv_dir(p[0], p[1], p[2], wd, ad, lp['rw_w0'][d], lp['rw_w_up'][d],
                         lp['rw_a0'][d], lp['rw_a_up'][d], lp['rw_k_k'], lp['rw_k_a'])

    def gla_in(p, d):
        q = _heads(jax.nn.silu(p[3]) * GLA_DK ** -0.5, GLA_DK)
        k = _heads(jax.nn.silu(p[4]), GLA_DK)
        v = _heads(jax.nn.silu(p[5]), GLA_DV)
        ad = p[8][..., d * GLA_RANK:(d + 1) * GLA_RANK]
        log_a = jax.nn.log_sigmoid(ad @ lp['gla_a_up'][d] + lp['gla_a_b'][d]) / GLA_TAU
        return (q, k, v, _heads(log_a, GLA_DK))

    def bonus(ins):
        return jnp.sum(ins[0] * ins[2] * lp['rw_r_k'], axis=-1, keepdims=True) * ins[3]

    rw_c = rb_c = rw_l = rb_l = gla_c = gla_l = 0.0
    for d in range(2):
        rev = d == 1
        ic, il = rw_in(pc, d), rw_in(pl, d)
        oc, ol = _prefix_scan(_rwkv7_scan, ic, il, s0_rw, rev)
        rw_c, rw_l = rw_c + oc, rw_l + ol
        rb_c, rb_l = rb_c + bonus(ic), rb_l + bonus(il)
        gc_, gl_ = _prefix_scan(_gla_chunked, gla_in(pc, d), gla_in(pl, d), s0_gla, rev)
        gla_c, gla_l = gla_c + gc_, gla_l + gl_
    return rw_c, rb_c, rw_l, rb_l, gla_c, gla_l


def _rwkv_post(o, bon, gd, lp):
    mu = jnp.mean(o, axis=-1, keepdims=True)
    var = jnp.mean(jnp.square(o - mu), axis=-1, keepdims=True)
    y = ((o - mu) * lax.rsqrt(var + RW_GN_EPS)).reshape(*o.shape[:-2], RW_WIDTH)
    y = y * lp['rw_ln_w'] + lp['rw_ln_b'] + bon.reshape(*o.shape[:-2], RW_WIDTH)
    return y * (jax.nn.sigmoid(gd) @ lp['rw_g_up'])


def _gla_post(o, og, lp):
    y = o * lax.rsqrt(jnp.mean(o * o, axis=-1, keepdims=True) + NORM_EPS) * lp['gla_norm_w']
    return y.reshape(*o.shape[:-2], GLA_VW) * jax.nn.silu(og)


def _fourier(u):
    b, t, _ = u.shape
    g = u.astype(jnp.float32).reshape(b, t, FN_GROUPS, FN_GROUP_DIM)
    return jnp.real(jnp.fft.fftn(g, axes=(1, 3), norm='ortho')).reshape(b, t, FN_WIDTH)


def _merge(rw_y, gla_y, fn_y, gates, lp):
    ga, gb, gc = jnp.split(jax.nn.sigmoid(gates), N_BRANCH, axis=-1)
    m = ga * (rw_y @ lp['proj_a']) + gb * (gla_y @ lp['proj_b']) + gc * (fn_y @ lp['proj_c'])
    return m @ lp['w_out']


def _token_mixers(z_lat, z_ctx, lp, rows, col_major, need_ctx):
    offs = np.cumsum(np.array(IN_SPLITS))[:-1].tolist()

    def prep(z, r):
        conv = _short_conv(z[..., :CONV_CH], lp['conv_w'], r)
        zz = jnp.concatenate([conv, z[..., CONV_CH:]], axis=-1).astype(jnp.float32)
        return jnp.split(zz, offs, axis=-1)

    pl = prep(z_lat, rows)
    pc = prep(z_ctx, 1)
    scan_l = pl[:N_SCAN_PARTS]
    if col_major:
        scan_l = [_to_col_major(a, rows) for a in scan_l]
    rw_c, rb_c, rw_l, rb_l, gla_c, gla_l = _scan_branches(pc[:N_SCAN_PARTS], scan_l, lp)
    if col_major:
        rw_l, rb_l, gla_l = (_from_col_major(rw_l, rows), _from_col_major(rb_l, rows),
                             _from_col_major(gla_l, rows))

    def post(p, rw_o, rb_o, gla_o):
        return _merge(_rwkv_post(rw_o, rb_o, p[9], lp), _gla_post(gla_o, p[10], lp),
                      _fourier(p[11]), p[12], lp)

    m_lat = post(pl, rw_l, rb_l, gla_l).astype(z_lat.dtype)
    m_ctx = post(pc, rw_c, rb_c, gla_c).astype(z_ctx.dtype) if need_ctx else None
    return m_lat, m_ctx


def _ec_moe(u, lp):
    b, t, _ = u.shape
    cap = CAPACITY_FACTOR * t // N_EXPERTS
    aff = jax.nn.softmax((u @ lp['router']).astype(jnp.float32), axis=-1)
    gate, idx = lax.top_k(jnp.swapaxes(aff, 1, 2), cap)
    bidx = jnp.arange(b)[:, None, None]
    xs = u[bidx, idx]
    hid = jax.nn.silu(jnp.einsum('becd,edf->becf', xs, lp['w1'])) * jnp.einsum('becd,edf->becf', xs, lp['w3'])
    ys = jnp.einsum('becf,efd->becd', hid, lp['w2']) * gate[..., None].astype(u.dtype)
    return jnp.zeros_like(u).at[bidx, idx].add(ys.astype(u.dtype))


def _layer(h_lat, h_ctx, mod_lat, mod_ctx, lp, rows, col_major, need_ctx):
    sh1, sc1, g1, sh2, sc2, g2 = jnp.split(mod_lat[:, None, :], N_MOD, axis=-1)
    csh1, csc1, cg1, csh2, csc2, cg2 = jnp.split(mod_ctx, N_MOD, axis=-1)
    u_lat = _rmsnorm(h_lat, lp['norm1']) * (1.0 + sc1) + sh1
    u_ctx = _rmsnorm(h_ctx, lp['norm1']) * (1.0 + csc1) + csh1
    m_lat, m_ctx = _token_mixers(u_lat @ lp['w_in'], u_ctx @ lp['w_in'], lp, rows, col_major, need_ctx)
    h_lat = h_lat + g1 * m_lat
    v_lat = _rmsnorm(h_lat, lp['norm2']) * (1.0 + sc2) + sh2
    h_lat = h_lat + g2 * _ec_moe(v_lat, lp)
    if need_ctx:
        h_ctx = h_ctx + cg1 * m_ctx
        v_ctx = _rmsnorm(h_ctx, lp['norm2']) * (1.0 + csc2) + csh2
        h_ctx = h_ctx + cg2 * _ec_moe(v_ctx, lp)
    return h_lat, h_ctx


def setup_inputs(seed: int = 0) -> dict:
    key = jax.random.key(seed)
    ks = iter(jax.random.split(key, 40))
    nrm = lambda shape, scale: jax.random.normal(next(ks), shape, jnp.float32) * scale
    L, D, E, F = DEPTH, D_MODEL, N_EXPERTS, EXPERT_HIDDEN
    return {
        'x': nrm((BATCH, SEQ, D), 1.0),
        'c': nrm((BATCH, D), 1.0),
        'ctx': nrm((BATCH, CTX_LEN, D), 1.0),
        'c_ctx': nrm((D,), 1.0),
        'w_mod': nrm((L, D, N_MOD * D), 0.5 * D ** -0.5),
        'b_mod': nrm((L, N_MOD * D), 0.01),
        'norm1_w': 1.0 + nrm((L, D), 0.02),
        'norm2_w': 1.0 + nrm((L, D), 0.02),
        'w_in': nrm((L, D, IN_COLS), D ** -0.5),
        'conv_w': nrm((L, CONV_K, CONV_K, CONV_CH), 1.0 / CONV_K),
        'rw_w0': nrm((L, 2, RW_WIDTH), 0.5),
        'rw_w_up': nrm((L, 2, RW_DECAY_RANK, RW_WIDTH), RW_DECAY_RANK ** -0.5),
        'rw_a0': nrm((L, 2, RW_WIDTH), 0.5),
        'rw_a_up': nrm((L, 2, RW_A_RANK, RW_WIDTH), RW_A_RANK ** -0.5),
        'rw_k_k': 0.85 + nrm((L, RW_WIDTH), 0.02),
        'rw_k_a': 1.0 + nrm((L, RW_WIDTH), 0.02),
        'rw_r_k': nrm((L, RW_HEADS, RW_HEAD_DIM), 0.1),
        'rw_g_up': nrm((L, RW_GATE_RANK, RW_WIDTH), RW_GATE_RANK ** -0.5),
        'rw_ln_w': 1.0 + nrm((L, RW_WIDTH), 0.02),
        'rw_ln_b': nrm((L, RW_WIDTH), 0.01),
        'gla_a_up': nrm((L, 2, GLA_RANK, GLA_KW), GLA_RANK ** -0.5),
        'gla_a_b': nrm((L, 2, GLA_KW), 0.1),
        'gla_norm_w': 1.0 + nrm((L, GLA_DV), 0.02),
        'proj_a': nrm((L, RW_WIDTH, D), RW_WIDTH ** -0.5),
        'proj_b': nrm((L, GLA_VW, D), GLA_VW ** -0.5),
        'proj_c': nrm((L, FN_WIDTH, D), FN_WIDTH ** -0.5),
        'w_out': nrm((L, D, D), D ** -0.5),
        'router': nrm((L, D, E), D ** -0.5),
        'exp_w1': nrm((L, E, D, F), D ** -0.5),
        'exp_w3': nrm((L, E, D, F), D ** -0.5),
        'exp_w2': nrm((L, E, F, D), F ** -0.5),
        'final_norm_w': 1.0 + nrm((D,), 0.02),
    }


def reference(x, c, ctx, c_ctx, w_mod, b_mod, norm1_w, norm2_w, w_in, conv_w, rw_w0, rw_w_up, rw_a0,
              rw_a_up, rw_k_k, rw_k_a, rw_r_k, rw_g_up, rw_ln_w, rw_ln_b, gla_a_up, gla_a_b, gla_norm_w,
              proj_a, proj_b, proj_c, w_out, router, exp_w1, exp_w3, exp_w2, final_norm_w):
    rows = x.shape[1] // GRID_W
    h_lat, h_ctx = x, ctx
    for i in range(DEPTH):
        lp = {'norm1': norm1_w[i], 'norm2': norm2_w[i], 'w_in': w_in[i], 'conv_w': conv_w[i],
              'rw_w0': rw_w0[i], 'rw_w_up': rw_w_up[i], 'rw_a0': rw_a0[i], 'rw_a_up': rw_a_up[i],
              'rw_k_k': rw_k_k[i], 'rw_k_a': rw_k_a[i], 'rw_r_k': rw_r_k[i], 'rw_g_up': rw_g_up[i],
              'rw_ln_w': rw_ln_w[i], 'rw_ln_b': rw_ln_b[i], 'gla_a_up': gla_a_up[i], 'gla_a_b': gla_a_b[i],
              'gla_norm_w': gla_norm_w[i], 'proj_a': proj_a[i], 'proj_b': proj_b[i], 'proj_c': proj_c[i],
              'w_out': w_out[i], 'router': router[i], 'w1': exp_w1[i], 'w3': exp_w3[i], 'w2': exp_w2[i]}
        mod_lat = jax.nn.silu(c) @ w_mod[i] + b_mod[i]
        mod_ctx = jax.nn.silu(c_ctx) @ w_mod[i] + b_mod[i]
        h_lat, h_ctx = _layer(h_lat, h_ctx, mod_lat, mod_ctx, lp, rows,
                              col_major=(i % 2 == 1), need_ctx=(i < DEPTH - 1))
    return _rmsnorm(h_lat, final_norm_w)
```

```cpp
#include <hip/hip_runtime.h>
#include <cstdio>
#include <cstdint>

#ifndef N_LAUNCH_MODE
#define N_LAUNCH_MODE 1
#endif

namespace pg8 {
#define PG8_LAS __attribute__((address_space(3)))
typedef unsigned short bf16_t;
typedef short bf16x8 __attribute__((ext_vector_type(8)));
typedef float f32x4 __attribute__((ext_vector_type(4)));
typedef unsigned u32x4 __attribute__((ext_vector_type(4)));
constexpr int BM = 256, BK = 64, HALF = 128, HTB = HALF * BK * 2  , STAGE_BYTES = 8 * HTB, NXCD = 8, WGM = 8;

__host__ __device__ __forceinline__ int lds_byte(int r, int c) { const int st = (r >> 4) * 2 + (c >> 5), rr = r & 15, cc = c & 31, ob = rr * 64 + cc * 2; return st * 1024 + (ob ^ (((ob >> 9) & 1) << 5)); }
__host__ __device__ __forceinline__ void stage_rc(int b, int& R, int& C) { const int st = b / 1024, sb = b % 1024, swz = sb ^ (((sb >> 9) & 1) << 5); R = (st >> 1) * 16 + swz / 64; C = (st & 1) * 32 + (swz % 64) / 2; }
__host__ __device__ __forceinline__ int perm32(int rho) { const int n = rho >> 4, i = rho & 15; return 8 * (i >> 2) + 4 * n + (i & 3); }

struct Unit { int pm, pn, koff, nt, aux; };
struct Gemm { const bf16_t* A; const bf16_t* Bt; int M, N, K, lda, ldb; };

struct StaticOrder {
    int nM, nN, nwg, G, c;
    __host__ __device__ void init(int M, int N, int G_, int c_) { nM = M / BM; nN = N / BM; nwg = nM * nN; G = G_; c = c_; }
    __host__ __device__ bool next(int i, Unit& u) const {
        const long L = (long)i * G + c; if (L >= nwg) return false;
        int wgid = (int)L; { const int q = nwg / NXCD, r = nwg % NXCD, xcd = wgid % NXCD, off = wgid / NXCD; wgid = (xcd < r ? xcd * (q + 1) : r * (q + 1) + (xcd - r) * q) + off; }
        const int nig = WGM * nN, gid = wgid / nig, fm = gid * WGM, gsz = (nM - fm) < WGM ? (nM - fm) : WGM;
        u.pm = fm + ((wgid % nig) % gsz); u.pn = (wgid % nig) / gsz; u.koff = 0; u.nt = 0; u.aux = 0; return true;
    }
    __device__ __forceinline__ void a_ready(const Unit&) const {}
    __device__ __forceinline__ void done(const Unit&) const {}
};
struct GroupOrder {
    int ngroups, nm, nn, G, c, gm, shb;
    __host__ __device__ void init(int ng_, int nm_, int nn_, int G_, int c_, int gm_, int shb_ = 0) { ngroups = ng_; nm = nm_; nn = nn_; G = G_; c = c_; gm = gm_; shb = shb_; }
    __host__ __device__ bool next(int i, Unit& u) const {
        u.koff = 0; u.nt = 0; u.aux = 0;
        const int per = nm * nn;
        if (G == 256 && (ngroups & 7) == 0) {
            const int x = c & 7, slot = c >> 3, gpx = ngroups >> 3; const long s = (long)i * 32 + slot; if (s >= (long)gpx * per) return false;
            const int grp = x * gpx + (int)(s / per), rem = (int)(s % per);
            const int nig = WGM * nn, gid = rem / nig, fm = gid * WGM, gsz = (nm - fm) < WGM ? (nm - fm) : WGM;
            u.pm = grp * gm + fm + ((rem % nig) % gsz); u.pn = grp * nn + (rem % nig) / gsz; return true; }
        const long L = (long)i * G + c; if (L >= (long)ngroups * per) return false;
        const int grp = (int)(L / per), rem = (int)(L % per);
        u.pm = grp * gm + rem % nm; u.pn = (shb ? 0 : grp * nn) + rem / nm; u.aux = grp; return true;
    }
    __device__ __forceinline__ void a_ready(const Unit&) const {}
    __device__ __forceinline__ void done(const Unit&) const {}
};
struct W2Order {
    GroupOrder base; bool split;
    __host__ __device__ void init(int ng_, int nm_, int G_, int c_, int gm_) { split = (nm_ == gm_ && G_ == 256 && ng_ == 16 && gm_ == 17); base.init(ng_, split ? nm_ - 1 : nm_, 4, G_, c_, gm_); }
    __host__ __device__ bool next(int i, Unit& u) const {
        if (base.next(i, u)) return true;
        if (!split || i != 4) return false;
        const int x = base.c & 7, sl = base.c >> 3, e = 2 * x + (sl >> 4);
        u.pm = e * 17 + 16; u.pn = e * 4 + ((sl >> 2) & 3); u.koff = (sl & 3) * 512; u.nt = 8; u.aux = sl & 3; return true;
    }
    __device__ __forceinline__ void a_ready(const Unit&) const {}
    __device__ __forceinline__ void done(const Unit&) const {}
};
struct LoraOrder {
    StaticOrder base;
    __host__ __device__ void init(int M, int N, int G_, int c_) { base.init(M, N, G_, c_); }
    __host__ __device__ bool next(int i, Unit& u) const { if (!base.next(i, u)) return false; const int p = u.pn; u.koff = p < 3 ? 0 : p < 6 ? 128 : 256; u.nt = p < 7 ? 2 : 4; return true; }
    __device__ __forceinline__ void a_ready(const Unit&) const {}
    __device__ __forceinline__ void done(const Unit&) const {}
};
struct Merge3Order {
    StaticOrder base;
    __host__ __device__ void init(int M, int N, int G_, int c_) { base.init(M, N, G_, c_); }
    __host__ __device__ bool next(int i, Unit& u) const { if (!base.next(i / 3, u)) return false; const int br = i % 3; u.aux = br; u.koff = 384 * br; u.nt = br < 2 ? 6 : 4; return true; }
    __device__ __forceinline__ void a_ready(const Unit&) const {}
    __device__ __forceinline__ void done(const Unit&) const {}
};
typedef float f32x2 __attribute__((ext_vector_type(2)));
typedef __bf16 bf16x2_hw __attribute__((ext_vector_type(2)));
__device__ __forceinline__ unsigned cvt_pk_bf16(float lo, float hi) { const f32x2 v = (f32x2){lo, hi}; return __builtin_bit_cast(unsigned, __builtin_convertvector(v, bf16x2_hw)); }

template <class Epi, class Sched>
__device__ __forceinline__ void gemm_phase(PG8_LAS unsigned char* lds, const Gemm g, const Sched& S, const Epi& E, int tid_in) {
    int tid_ = tid_in; asm volatile("" : "+v"(tid_));
    const int tid = tid_, wid = __builtin_amdgcn_readfirstlane(tid >> 6), lane = tid & 63, wr = wid >> 2, wc = wid & 3, fr = lane & 15, fq = lane >> 4;
    const int K = g.K, nt = K / BK;
    unsigned voffA[2], voffB[2];
#pragma unroll
    for (int i = 0; i < 2; ++i) { int R, C; stage_rc(tid * 16 + i * 8192, R, C); const int Rb = Epi::PERM ? ((R & ~31) + perm32(R & 31)) : R;
        voffA[i] = (unsigned)(R * g.lda + C) * 2u; voffB[i] = (unsigned)(Rb * g.ldb + C) * 2u; }
    const size_t kstep = (size_t)(BK * 2);
    const size_t hstepA = (size_t)HALF * g.lda * 2, hstepB = (size_t)HALF * g.ldb * 2;
    const size_t tstepA = 2 * hstepA, tstepB = 2 * hstepB;
    const unsigned ldsw = (unsigned)wid * 1024u;
    const int aoff = lds_byte(wr * 64 + fr, fq * 8), boff = lds_byte(wc * 32 + fr, fq * 8);
#define PG8_SA(b, h) (((b) * 2 + (h)) * HTB)
#define PG8_SB(b, h) ((4 + (b) * 2 + (h)) * HTB)
#define PG8_STAGE(bufoff, gbase, voff) do { _Pragma("unroll") for (int _i = 0; _i < 2; ++_i) \
        __builtin_amdgcn_global_load_lds((const unsigned*)((const char*)(gbase) + (voff)[_i]), (PG8_LAS unsigned*)(lds + (bufoff) + ldsw + _i * 8192), 16, 0, 0); } while (0)
#define PG8_LDA(dst, b, h) do { _Pragma("unroll") for (int m = 0; m < 4; ++m) _Pragma("unroll") for (int k = 0; k < 2; ++k) dst[m][k] = *(const PG8_LAS bf16x8*)(lds + PG8_SA(b, h) + aoff + m * 2048 + k * 1024); } while (0)
#define PG8_LDB(dst, b, h) do { _Pragma("unroll") for (int n = 0; n < 2; ++n) _Pragma("unroll") for (int k = 0; k < 2; ++k) dst[n][k] = *(const PG8_LAS bf16x8*)(lds + PG8_SB(b, h) + boff + n * 2048 + k * 1024); } while (0)
#define PG8_MMA(ai, bj, At, Bt) do { __builtin_amdgcn_s_setprio(1); _Pragma("unroll") for (int m = 0; m < 4; ++m) _Pragma("unroll") for (int n = 0; n < 2; ++n) _Pragma("unroll") for (int k = 0; k < 2; ++k) \
        acc[ai][bj][m][n] = __builtin_amdgcn_mfma_f32_16x16x32_bf16(Bt[n][k], At[m][k], acc[ai][bj][m][n], 0, 0, 0); __builtin_amdgcn_s_setprio(0); } while (0)
#define PG8_WAIT_V(n) asm volatile("s_waitcnt vmcnt(" #n ")" ::: "memory")
#define PG8_WAIT_L(n) asm volatile("s_waitcnt lgkmcnt(" #n ")" ::: "memory")
#define PG8_BAR __builtin_amdgcn_s_barrier()
#define PG8_SCHED __builtin_amdgcn_sched_barrier(0)
    Unit cur, nxt; int ui = 0;
    if (!S.next(0, cur)) return;
    f32x4 acc[2][2][4][2];
#pragma unroll
    for (int a = 0; a < 2; ++a)
#pragma unroll
        for (int b = 0; b < 2; ++b)
#pragma unroll
            for (int m = 0; m < 4; ++m)
#pragma unroll
                for (int n = 0; n < 2; ++n) acc[a][b][m][n] = (f32x4){0.f, 0.f, 0.f, 0.f};
    bf16x8 At[4][2], B0[2][2], B1[2][2];
    const char* cA = (const char*)g.A + (size_t)cur.pm * tstepA + 2 * cur.koff; const char* cB = (const char*)g.Bt + (size_t)cur.pn * tstepB + 2 * cur.koff;
    S.a_ready(cur);
    PG8_STAGE(PG8_SB(0, 0), cB, voffB); PG8_STAGE(PG8_SA(0, 0), cA, voffA); PG8_STAGE(PG8_SB(0, 1), cB + hstepB, voffB); PG8_STAGE(PG8_SA(0, 1), cA + hstepA, voffA);
    if (wr == 1) PG8_BAR;
    PG8_WAIT_V(4); PG8_BAR;
    PG8_STAGE(PG8_SB(1, 0), cB + kstep, voffB); PG8_STAGE(PG8_SA(1, 0), cA + kstep, voffA); PG8_STAGE(PG8_SB(1, 1), cB + hstepB + kstep, voffB);
    PG8_WAIT_V(6); PG8_BAR;
    for (;;) {
        const bool has_next = S.next(ui + 1, nxt);
        const char* nA = has_next ? (const char*)g.A + (size_t)nxt.pm * tstepA + 2 * nxt.koff : cA; const char* nB = has_next ? (const char*)g.Bt + (size_t)nxt.pn * tstepB + 2 * nxt.koff : cB;
        const int cnt = cur.nt ? cur.nt : nt;
        for (int t = 0; t < cnt; t += 2) {
            const bool last = (t == cnt - 2);
            if constexpr (Epi::HAS_MID) { if (t == Epi::MID0 || t == Epi::MID1) E.mid(acc, cur, t, wr, wc, fr, fq); }
            const char* a1 = cA + (size_t)(t + 1) * kstep;
            const char* a2 = last ? nA : cA + (size_t)(t + 2) * kstep; const char* b2 = last ? nB : cB + (size_t)(t + 2) * kstep;
            const char* a3 = a2 + kstep; const char* b3 = b2 + kstep;
            if (last && has_next) S.a_ready(nxt);
            PG8_LDB(B0, 0, 0); PG8_SCHED; PG8_LDA(At, 0, 0); PG8_STAGE(PG8_SA(1, 1), a1 + hstepA, voffA);
            PG8_WAIT_L(8); PG8_BAR; PG8_WAIT_L(0); PG8_MMA(0, 0, At, B0); PG8_BAR; PG8_SCHED;
            PG8_LDB(B1, 0, 1); PG8_STAGE(PG8_SB(0, 0), b2, voffB);
            PG8_BAR; PG8_WAIT_L(0); PG8_MMA(0, 1, At, B1); PG8_BAR;
            PG8_LDA(At, 0, 1); PG8_STAGE(PG8_SA(0, 0), a2, voffA);
            PG8_BAR; PG8_WAIT_L(0); PG8_MMA(1, 0, At, B0); PG8_BAR; PG8_SCHED;
            PG8_STAGE(PG8_SB(0, 1), b2 + hstepB, voffB);
            PG8_WAIT_V(6); PG8_BAR; PG8_MMA(1, 1, At, B1); PG8_BAR;
            PG8_LDB(B0, 1, 0); PG8_SCHED; PG8_LDA(At, 1, 0); PG8_STAGE(PG8_SA(0, 1), a2 + hstepA, voffA);
            PG8_WAIT_L(8); PG8_BAR; PG8_WAIT_L(0); PG8_MMA(0, 0, At, B0); PG8_BAR; PG8_SCHED;
            PG8_LDB(B1, 1, 1); PG8_STAGE(PG8_SB(1, 0), b3, voffB);
            PG8_BAR; PG8_WAIT_L(0); PG8_MMA(0, 1, At, B1); PG8_BAR;
            PG8_LDA(At, 1, 1); PG8_STAGE(PG8_SA(1, 0), a3, voffA);
            PG8_BAR; PG8_WAIT_L(0); PG8_MMA(1, 0, At, B0); PG8_BAR; PG8_SCHED;
            PG8_STAGE(PG8_SB(1, 1), b3 + hstepB, voffB);
            PG8_WAIT_V(6); PG8_BAR; PG8_MMA(1, 1, At, B1); PG8_BAR;
        }
        if constexpr (!Epi::AFTER_DRAIN) { E(acc, cur, wr, wc, fr, fq); S.done(cur); }
        if (!has_next) break;
#pragma unroll
        for (int a = 0; a < 2; ++a)
#pragma unroll
            for (int b = 0; b < 2; ++b)
#pragma unroll
                for (int m = 0; m < 4; ++m)
#pragma unroll
                    for (int n = 0; n < 2; ++n) acc[a][b][m][n] = (f32x4){0.f, 0.f, 0.f, 0.f};
        cur = nxt; cA = nA; cB = nB; ++ui;
    }
    PG8_WAIT_V(0);
    if (wr == 0) PG8_BAR;
    PG8_BAR;
    if constexpr (Epi::AFTER_DRAIN) { E.fused(acc, cur, wr, wc, fr, fq, lds, wid, lane); S.done(cur); }
#undef PG8_SA
#undef PG8_SB
#undef PG8_STAGE
#undef PG8_LDA
#undef PG8_LDB
#undef PG8_MMA
#undef PG8_WAIT_V
#undef PG8_WAIT_L
#undef PG8_BAR
#undef PG8_SCHED
}
}

#define XB_TMO      128
#define XB_XCNT(j)  (256  + 64 * (j))
#define XB_XSUB(j)  (1280 + 64 * (j))
#define XB_XGEN(j)  (2304 + 64 * (j))
#define XB_TOP      3328
#define XB_TOPGEN   3392
#define XCD_BAR_WORDS 3456
#define XB_SPIN_CAP (1u << 22)
#define LAS __attribute__((address_space(3)))

__device__ __forceinline__ unsigned xb_ld(unsigned* p)              { return __hip_atomic_load(p, __ATOMIC_RELAXED, __HIP_MEMORY_SCOPE_AGENT); }
__device__ __forceinline__ unsigned xb_add(unsigned* p, unsigned v) { return __hip_atomic_fetch_add(p, v, __ATOMIC_RELAXED, __HIP_MEMORY_SCOPE_AGENT); }
__device__ __forceinline__ unsigned xb_xcc_id() { return (unsigned)__builtin_amdgcn_s_getreg((3 << 11) | 20) & 0xFu; }
#define XB_SPIN(cond, bar) do { unsigned _sp = 0; while (cond) { __builtin_amdgcn_s_sleep(1); \
    if ((++_sp & 255u) == 0u) { if (xb_ld(&(bar)[XB_TMO])) break; if (_sp > XB_SPIN_CAP) { atomicAdd(&(bar)[XB_TMO], 1u); break; } } } } while (0)

struct XcdBarrier {
    unsigned* bar; unsigned x;
    volatile LAS unsigned* st;
};

__device__ __forceinline__ XcdBarrier xcd_barrier_post(unsigned* bar, volatile LAS unsigned* st) {
    XcdBarrier b; b.bar = bar; b.x = xb_xcc_id(); b.st = st;
    if (threadIdx.x == 0) (void)xb_add(&bar[XB_XCNT(b.x)], 1u);
    return b;
}
__device__ __forceinline__ void xcd_barrier_complete(unsigned* bar, unsigned x, unsigned& nloc, unsigned& nx) {
    const unsigned G = gridDim.x * gridDim.y * gridDim.z;
    unsigned sum, cnt, mine, sp = 0u;
    for (;;) {
        sum = 0u; cnt = 0u; mine = 0u;
#pragma unroll
        for (unsigned j = 0; j < 16; ++j) { const unsigned c = xb_ld(&bar[XB_XCNT(j)]); sum += c; cnt += (c > 0u) ? 1u : 0u; mine = (j == x) ? c : mine; }
        if (sum == G) break;
        __builtin_amdgcn_s_sleep(1);
        if ((++sp & 255u) == 0u) { if (xb_ld(&bar[XB_TMO])) break; if (sp > XB_SPIN_CAP) { atomicAdd(&bar[XB_TMO], 1u); break; } }
    }
    nloc = mine > 0u ? mine : 1u; nx = cnt > 0u ? cnt : 1u;
}

__device__ __forceinline__ void xcd_barrier(const XcdBarrier& b) {
    asm volatile("s_waitcnt vmcnt(0)" ::: "memory");
    __syncthreads();
    if (threadIdx.x == 0) {
        unsigned* bar = b.bar;
        __builtin_amdgcn_s_waitcnt(0);
        unsigned nloc = b.st[0], nx = b.st[1];
        if (nloc == 0u) { xcd_barrier_complete(bar, b.x, nloc, nx); b.st[0] = nloc; b.st[1] = nx; }
        const unsigned old = xb_add(&bar[XB_XSUB(b.x)], 1u);
        const unsigned gen = old / nloc;
        if (old + 1u == (gen + 1u) * nloc) {
            __builtin_amdgcn_fence(__ATOMIC_RELEASE, "agent");
            asm volatile("s_waitcnt vmcnt(0)" ::: "memory");
            const unsigned og = xb_add(&bar[XB_TOP], 1u);
            const unsigned tg = og / nx;
            if (og + 1u == (tg + 1u) * nx) xb_add(&bar[XB_TOPGEN], 1u);
            else XB_SPIN(xb_ld(&bar[XB_TOPGEN]) == tg, bar);
            __builtin_amdgcn_fence(__ATOMIC_ACQUIRE, "agent");
            xb_add(&bar[XB_XGEN(b.x)], 1u);
            asm volatile("s_waitcnt vmcnt(0)" ::: "memory");
        } else {
            XB_SPIN(xb_ld(&bar[XB_XGEN(b.x)]) == gen, bar);
            __builtin_amdgcn_fence(__ATOMIC_ACQUIRE, "agent");
            asm volatile("s_waitcnt vmcnt(0)" ::: "memory");
        }
    }
    __syncthreads();
}

typedef unsigned short bf16;
typedef float f32x4 __attribute__((ext_vector_type(4)));
typedef float f32x2 __attribute__((ext_vector_type(2)));
typedef unsigned u32x4 __attribute__((ext_vector_type(4)));
typedef unsigned u32x2 __attribute__((ext_vector_type(2)));

constexpr int D = 1024, NB = 8, SEQ = 4096, CTXL = 256, DEPTH = 4;
constexpr int ML = NB * SEQ, MC = NB * CTXL, MT = ML + MC;
constexpr int NZ = 6144, INCOLS = 6048;
constexpr int RW = 384, GKW = 192, GVW = 384, FNW = 256, CONVC = 1920;
constexpr int ZC_R = 0, ZC_K = 384, ZC_V = 768, ZC_GQ = 1152, ZC_GK = 1344, ZC_GV = 1536, ZC_LIN = 1920, ZC_OG = 2336, ZC_FP = 2720, ZC_GATE = 2976, ZC_END = 6048;
constexpr int SRC_FN = 2720, SRC_GATE = 2976;
constexpr int NE = 16, EH = 2048, CAPL = 512, CAPC = 32, ME = NB * CAPL + NB * CAPC  , MXR = NE * ME  ;
constexpr int LK = 512, LN = 2304;
constexpr int NTHR = 512, NWAVE = 8;
constexpr float NORM_EPS = 1e-6f, RW_GN_EPS = 64e-5f;

constexpr size_t KiB = 1024, MiB = 1024 * 1024;
constexpr size_t al256(size_t x) { return (x + 255) & ~(size_t)255; }
constexpr size_t O_CTL  = 0,                         SZ_CTL  = 1 * MiB;
constexpr size_t O_MOD  = O_CTL + SZ_CTL,            SZ_MOD  = al256((size_t)DEPTH * 9 * 6144 * 4);
constexpr size_t O_AFFL = O_MOD + SZ_MOD,            SZ_AFFL = (size_t)NB * NE * SEQ * 4;
constexpr size_t O_AFFC = O_AFFL + SZ_AFFL,          SZ_AFFC = (size_t)NB * NE * CTXL * 4;
constexpr size_t O_TOK  = O_AFFC + SZ_AFFC,          SZ_TOK  = al256((size_t)MXR * 4);
constexpr size_t O_GATE = O_TOK + SZ_TOK,            SZ_GATE = al256((size_t)MXR * 4);
constexpr size_t O_SEL  = O_GATE + SZ_GATE,          SZ_SEL  = (size_t)MT * NE * 4;
constexpr size_t O_FOC  = O_SEL + SZ_SEL,              SZ_FOC  = (size_t)MC * 256 * 4;
constexpr size_t O_H    = O_FOC + SZ_FOC,            SZ_H    = (size_t)MT * D * 4;
constexpr size_t O_U    = O_H + SZ_H,                SZ_U    = (size_t)MT * D * 2;
constexpr size_t O_Z    = O_U + SZ_U,                SZ_Z    = (size_t)MT * NZ * 2;
constexpr size_t O_XS   = O_Z,                       SZ_XS   = (size_t)MXR * D * 2;
constexpr size_t O_HID  = O_XS + SZ_XS,              SZ_HID  = (size_t)MXR * EH * 2;
static_assert(SZ_XS + SZ_HID <= SZ_Z, "XS|HID overlay Z");
constexpr size_t O_KT   = O_Z + SZ_Z,                SZ_KT   = (size_t)MT * RW * 2;
constexpr size_t O_LO   = O_KT + SZ_KT,            SZ_LO   = (size_t)MT * LN * 2;
constexpr size_t O_RR   = O_LO + SZ_LO,              SZ_R384 = (size_t)MT * RW * 2;
constexpr size_t O_RV   = O_RR + SZ_R384;
constexpr size_t O_RKK  = O_RV + SZ_R384;
constexpr size_t O_RKM  = O_RKK + SZ_R384;
constexpr size_t O_YP   = O_RKM;
constexpr size_t O_RBB  = O_RKM + 2 * SZ_R384;
constexpr size_t O_RLD  = O_RBB + 2 * SZ_R384,       SZ_F384 = (size_t)MT * RW * 4;
constexpr size_t O_GQ   = O_RLD + 2 * SZ_F384,       SZ_G192 = (size_t)MT * GKW * 2;
constexpr size_t O_GK   = O_GQ + SZ_G192;
constexpr size_t O_GV   = O_GK + SZ_G192;
constexpr size_t O_GLA  = O_GV + SZ_R384,            SZ_F192 = (size_t)MT * GKW * 4;
constexpr size_t O_ORW  = O_GLA + 2 * SZ_F192;
constexpr size_t O_OGL  = O_ORW + 2 * SZ_F384;
constexpr size_t O_BON  = O_OGL + 2 * SZ_F384;
constexpr size_t O_BS   = O_BON;
constexpr size_t O_Y    = O_BON + SZ_F384,           SZ_Y    = (size_t)MT * D * 2;
constexpr size_t O_MX   = O_Y + SZ_Y;
constexpr size_t O_ADFT = O_MX + SZ_Y,               SZ_ADFT = (size_t)2 * SEQ * SEQ * 2;
constexpr size_t O_FCT  = O_ADFT + SZ_ADFT,          SZ_FCT  = (size_t)2 * 2048 * SEQ * 2;
constexpr size_t O_FO   = O_FCT + SZ_FCT,            SZ_FO   = (size_t)2 * ML * 256 * 4;
constexpr size_t O_WIN  = O_FO + SZ_FO,              SZ_WIN  = (size_t)NZ * D * 2;
constexpr size_t O_LORA = O_WIN + SZ_WIN,            SZ_LORA = (size_t)LN * LK * 2;
constexpr size_t O_PT   = O_LORA + SZ_LORA,          SZ_PT   = (size_t)D * D * 2;
constexpr size_t O_WOT  = O_PT + SZ_PT;
constexpr size_t O_W13  = O_WOT + SZ_PT,             SZ_W13  = (size_t)NE * 4096 * D * 2;
constexpr size_t O_W2T  = O_W13 + SZ_W13,            SZ_W2T  = (size_t)NE * D * EH * 2;
constexpr size_t WS_END = O_W2T + SZ_W2T;
static_assert(WS_END <= (size_t)2048 * MiB, "workspace map must fit 2 GiB");

constexpr int LDS_MAIN = 163584;
constexpr int LDS_MISC = LDS_MAIN;
constexpr int LDS_BYTES = 163840;

__device__ __forceinline__ float bflo(unsigned u) { return __uint_as_float(u << 16); }
__device__ __forceinline__ float bfhi(unsigned u) { return __uint_as_float(u & 0xffff0000u); }
__device__ __forceinline__ float bf1(bf16 v) { return __uint_as_float(((unsigned)v) << 16); }
typedef __bf16 bf16x2_hw __attribute__((ext_vector_type(2)));
__device__ __forceinline__ unsigned pk2(float lo, float hi) { const f32x2 v = (f32x2){lo, hi}; return __builtin_bit_cast(unsigned, __builtin_convertvector(v, bf16x2_hw)); }
__device__ __forceinline__ unsigned f2bf(float f) { return pk2(f, 0.f) & 0xffffu; }
__device__ __forceinline__ float sigmoid_f(float x) { return __builtin_amdgcn_rcpf(1.f + __expf(-x)); }
__device__ __forceinline__ float silu_f(float x) { return x * __builtin_amdgcn_rcpf(1.f + __expf(-x)); }
__device__ __forceinline__ float logsigmoid_f(float x) { return fminf(x, 0.f) - __logf(1.f + __expf(-fabsf(x))); }
__device__ __forceinline__ float wave_sum(float v) {
#pragma unroll
    for (int o = 1; o < 64; o <<= 1) v += __shfl_xor(v, o);
    return v;
}
__device__ __forceinline__ float half_sum(float v) {
#pragma unroll
    for (int o = 1; o < 32; o <<= 1) v += __shfl_xor(v, o);
    return v;
}
template <int CTRL> __device__ __forceinline__ float dpp_mov(float v) { return __builtin_bit_cast(float, __builtin_amdgcn_update_dpp(0, __builtin_bit_cast(int, v), CTRL, 0xF, 0xF, true)); }
template <int N> __device__ __forceinline__ float dpp_shr(float v) { return __builtin_bit_cast(float, __builtin_amdgcn_update_dpp(0, __builtin_bit_cast(int, v), 0x110 + N, 0xF, 0xF, true)); }
__device__ __forceinline__ float row_scan16(float v) { v += dpp_shr<1>(v); v += dpp_shr<2>(v); v += dpp_shr<4>(v); v += dpp_shr<8>(v); return v; }
__device__ __forceinline__ float sum4(float v)  { v += dpp_mov<0xB1>(v); v += dpp_mov<0x4E>(v); return v; }
__device__ __forceinline__ float sum8(float v)  { v = sum4(v); v += dpp_mov<0x141>(v); return v; }
__device__ __forceinline__ float sum16(float v) { v = sum8(v); v += dpp_mov<0x140>(v); return v; }
__device__ __forceinline__ float rdlane(float v, int l) { return __builtin_bit_cast(float, __builtin_amdgcn_readlane(__builtin_bit_cast(int, v), l)); }
__device__ __forceinline__ float wave_sum_fast(float v) { v = sum16(v); return (rdlane(v, 0) + rdlane(v, 16)) + (rdlane(v, 32) + rdlane(v, 48)); }
__device__ __forceinline__ float half_sum_fast(float v) { v = sum16(v); return v + __shfl_xor(v, 16); }
__device__ __forceinline__ int mod_index(int r) { return r < ML ? (r >> 12) : 8; }
__device__ __forceinline__ int scan_row(int r, int cm) {
    if (r >= ML || !cm) return r;
    const int t = r & 4095; return (r & ~4095) | ((t & 63) << 6) | (t >> 6);
}

struct Args { const float* in[32]; float* out; unsigned char* ws; int lo, hi; };
struct Ctx {
    float* out; unsigned char* ws; LAS unsigned char* lds;
    int tid, lane, wave, bid, nb;
};
#define LDS_WAIT() asm volatile("s_waitcnt lgkmcnt(0)" ::: "memory")

using pg8::Unit;
typedef f32x4 AccT[2][2][4][2];

struct EpiBf16Store {
    static constexpr bool PERM = true, AFTER_DRAIN = false, HAS_MID = false; static constexpr int MID0 = -1, MID1 = -1;
    bf16* O; int ldc;
    __device__ __forceinline__ void mid(AccT&, const Unit&, int, int, int, int, int) const {}
    __device__ __forceinline__ void operator()(const AccT& acc, const Unit& u, int wr, int wc, int fr, int fq) const {
        const int row0 = u.pm * 256 + wr * 64 + fr, col0 = u.pn * 256 + wc * 32 + 8 * fq;
#pragma unroll
        for (int ai = 0; ai < 2; ++ai)
#pragma unroll
            for (int m = 0; m < 4; ++m) { const int row = row0 + ai * 128 + m * 16; bf16* rowp = O + (size_t)row * ldc + col0;
#pragma unroll
                for (int bj = 0; bj < 2; ++bj) { const f32x4 v0 = acc[ai][bj][m][0], v1 = acc[ai][bj][m][1];
                    u32x4 w; w.x = pg8::cvt_pk_bf16(v0[0], v0[1]); w.y = pg8::cvt_pk_bf16(v0[2], v0[3]); w.z = pg8::cvt_pk_bf16(v1[0], v1[1]); w.w = pg8::cvt_pk_bf16(v1[2], v1[3]);
                    *(u32x4*)(rowp + bj * 128) = w; } }
    }
};
struct EpiZ {
    static constexpr bool PERM = true, AFTER_DRAIN = false, HAS_MID = false; static constexpr int MID0 = -1, MID1 = -1;
    bf16* Z; bf16* FCT;
    __device__ __forceinline__ void mid(AccT&, const Unit&, int, int, int, int, int) const {}
    __device__ __forceinline__ void operator()(const AccT& acc, const Unit& u, int wr, int wc, int fr, int fq) const {
        const int row0 = u.pm * 256 + wr * 64 + fr, col0 = u.pn * 256 + wc * 32 + 8 * fq;
        const bool lat = u.pm < 128;
#pragma unroll
        for (int bj = 0; bj < 2; ++bj) {
            const int c0 = col0 + bj * 128;
            const int kind = ((c0 >= 1920 && c0 < 1984) || (c0 >= 2048 && c0 < 2112)) ? 1 : ((c0 >= 2208 && c0 < 2336) || (c0 >= ZC_GATE && c0 < ZC_END)) ? 2 : (c0 >= ZC_FP && c0 < ZC_GATE && lat) ? 3 : 0;
#pragma unroll
            for (int ai = 0; ai < 2; ++ai)
#pragma unroll
                for (int m = 0; m < 4; ++m) { const int row = row0 + ai * 128 + m * 16;
                    float v[8];
#pragma unroll
                    for (int e = 0; e < 8; ++e) v[e] = acc[ai][bj][m][e >> 2][e & 3];
                    if (kind == 1) {
#pragma unroll
                        for (int e = 0; e < 8; ++e) v[e] = 1.f - 2.f * __builtin_amdgcn_rcpf(1.f + __expf(2.f * v[e]));
                    } else if (kind == 2) {
#pragma unroll
                        for (int e = 0; e < 8; ++e) v[e] = __builtin_amdgcn_rcpf(1.f + __expf(-v[e]));
                    }
                    if (kind == 3) {
                        bf16* p = FCT + ((size_t)((row >> 12) * 256 + (c0 - ZC_FP)) * SEQ + (row & 4095));
#pragma unroll
                        for (int e = 0; e < 8; ++e) p[(size_t)e * SEQ] = (bf16)f2bf(v[e]);
                    } else {
                        u32x4 w; w.x = pg8::cvt_pk_bf16(v[0], v[1]); w.y = pg8::cvt_pk_bf16(v[2], v[3]); w.z = pg8::cvt_pk_bf16(v[4], v[5]); w.w = pg8::cvt_pk_bf16(v[6], v[7]);
                        *(u32x4*)(Z + (size_t)row * NZ + c0) = w;
                    } }
        }
    }
};
struct EpiExpertOut {
    static constexpr bool PERM = true, AFTER_DRAIN = false, HAS_MID = false; static constexpr int MID0 = -1, MID1 = -1;
    bf16* O; const float* gate; bf16* YP;
    __device__ __forceinline__ void mid(AccT&, const Unit&, int, int, int, int, int) const {}
    __device__ __forceinline__ void operator()(const AccT& acc, const Unit& u, int wr, int wc, int fr, int fq) const {
        const int row0 = u.pm * 256 + wr * 64 + fr, col0 = (u.pn & 3) * 256 + wc * 32 + 8 * fq;
        bf16* Ob = u.aux ? YP : O; const int orow0 = u.aux ? (u.aux - 1) * 4096 + (u.pm / 17) * 256 + wr * 64 + fr : row0;
#pragma unroll
        for (int ai = 0; ai < 2; ++ai)
#pragma unroll
            for (int m = 0; m < 4; ++m) { const int row = row0 + ai * 128 + m * 16; bf16* rowp = Ob + (size_t)(orow0 + ai * 128 + m * 16) * D + col0; const float s = gate[row];
#pragma unroll
                for (int bj = 0; bj < 2; ++bj) { const f32x4 v0 = acc[ai][bj][m][0] * s, v1 = acc[ai][bj][m][1] * s;
                    u32x4 w; w.x = pg8::cvt_pk_bf16(v0[0], v0[1]); w.y = pg8::cvt_pk_bf16(v0[2], v0[3]); w.z = pg8::cvt_pk_bf16(v1[0], v1[1]); w.w = pg8::cvt_pk_bf16(v1[2], v1[3]);
                    *(u32x4*)(rowp + bj * 128) = w; } }
    }
};
struct EpiHid {
    static constexpr bool PERM = true, AFTER_DRAIN = false, HAS_MID = false; static constexpr int MID0 = -1, MID1 = -1;
    bf16* O;
    __device__ __forceinline__ void mid(AccT&, const Unit&, int, int, int, int, int) const {}
    __device__ __forceinline__ void operator()(const AccT& acc, const Unit& u, int wr, int wc, int fr, int fq) const {
        const int row0 = u.pm * 256 + wr * 64 + fr, col0 = (u.pn & 15) * 128 + wc * 32 + 8 * fq;
#pragma unroll
        for (int ai = 0; ai < 2; ++ai)
#pragma unroll
            for (int m = 0; m < 4; ++m) { bf16* rowp = O + (size_t)(row0 + ai * 128 + m * 16) * EH + col0;
                float h[8];
#pragma unroll
                for (int n = 0; n < 2; ++n)
#pragma unroll
                    for (int j = 0; j < 4; ++j) h[n * 4 + j] = silu_f(acc[ai][0][m][n][j]) * acc[ai][1][m][n][j];
                u32x4 w; w.x = pg8::cvt_pk_bf16(h[0], h[1]); w.y = pg8::cvt_pk_bf16(h[2], h[3]); w.z = pg8::cvt_pk_bf16(h[4], h[5]); w.w = pg8::cvt_pk_bf16(h[6], h[7]);
                *(u32x4*)rowp = w; }
    }
};
struct EpiMerge3 {
    static constexpr bool PERM = true, AFTER_DRAIN = false, HAS_MID = false; static constexpr int MID0 = -1, MID1 = -1;
    bf16* O; const bf16* Z;
    __device__ __forceinline__ void mid(AccT&, const Unit&, int, int, int, int, int) const {}
    __device__ __forceinline__ void operator()(const AccT& acc, const Unit& u, int wr, int wc, int fr, int fq) const {
        int row0 = u.pm * 256 + wr * 64 + fr; asm volatile("" : "+v"(row0));
        const int col0 = u.pn * 256 + wc * 32 + 8 * fq, br = u.aux;
        const char* zb = (const char*)Z; char* ob = (char*)O;
        const unsigned zoff = (unsigned)(ZC_GATE + 1024 * br + col0) * 2u;
#pragma unroll
        for (int ai = 0; ai < 2; ++ai) {
            u32x4 gz[4][2], mo[4][2];
#pragma unroll
            for (int m = 0; m < 4; ++m) { const unsigned row = (unsigned)(row0 + ai * 128 + m * 16);
#pragma unroll
                for (int bj = 0; bj < 2; ++bj) { gz[m][bj] = *(const u32x4*)(zb + row * (unsigned)(NZ * 2) + zoff + bj * 256);
                    if (br) mo[m][bj] = *(const u32x4*)(ob + row * (unsigned)(D * 2) + (unsigned)col0 * 2u + bj * 256); else mo[m][bj] = (u32x4){0u, 0u, 0u, 0u}; } }
#pragma unroll
            for (int m = 0; m < 4; ++m) { const unsigned row = (unsigned)(row0 + ai * 128 + m * 16);
#pragma unroll
                for (int bj = 0; bj < 2; ++bj) { float h[8];
#pragma unroll
                    for (int q = 0; q < 4; ++q) { h[2 * q] = acc[ai][bj][m][q >> 1][(q & 1) * 2] * bflo(gz[m][bj][q]) + bflo(mo[m][bj][q]); h[2 * q + 1] = acc[ai][bj][m][q >> 1][(q & 1) * 2 + 1] * bfhi(gz[m][bj][q]) + bfhi(mo[m][bj][q]); }
                    u32x4 w; w.x = pg8::cvt_pk_bf16(h[0], h[1]); w.y = pg8::cvt_pk_bf16(h[2], h[3]); w.z = pg8::cvt_pk_bf16(h[4], h[5]); w.w = pg8::cvt_pk_bf16(h[6], h[7]);
                    *(u32x4*)(ob + row * (unsigned)(D * 2) + (unsigned)col0 * 2u + bj * 256) = w; } }
            asm volatile("" ::: "memory");
        }
    }
};
struct EpiResid {
    static constexpr bool PERM = true, AFTER_DRAIN = false, HAS_MID = false; static constexpr int MID0 = -1, MID1 = -1;
    bf16* H; const float* modl;
    __device__ __forceinline__ void mid(AccT&, const Unit&, int, int, int, int, int) const {}
    __device__ __forceinline__ void operator()(const AccT& acc, const Unit& u, int wr, int wc, int fr, int fq) const {
        const int row0 = u.pm * 256 + wr * 64 + fr, col0 = u.pn * 256 + wc * 32 + 8 * fq;
        const int mi = u.pm < 128 ? (u.pm >> 4) : 8;
        const float* g = modl + (size_t)mi * 6144 + 2048 + col0;
        f32x4 gv[2][2];
#pragma unroll
        for (int bj = 0; bj < 2; ++bj)
#pragma unroll
            for (int n = 0; n < 2; ++n) gv[bj][n] = *(const f32x4*)(g + bj * 128 + n * 4);
#pragma unroll
        for (int ai = 0; ai < 2; ++ai) {
            u32x4 hv[4][2];
#pragma unroll
            for (int m = 0; m < 4; ++m)
#pragma unroll
                for (int bj = 0; bj < 2; ++bj) hv[m][bj] = *(const u32x4*)(H + (size_t)(row0 + ai * 128 + m * 16) * D + col0 + bj * 128);
#pragma unroll
            for (int m = 0; m < 4; ++m)
#pragma unroll
                for (int bj = 0; bj < 2; ++bj) { const f32x4 a0 = acc[ai][bj][m][0] * gv[bj][0], a1 = acc[ai][bj][m][1] * gv[bj][1]; const u32x4 o = hv[m][bj];
                    u32x4 w; w.x = pk2(bflo(o.x) + a0[0], bfhi(o.x) + a0[1]); w.y = pk2(bflo(o.y) + a0[2], bfhi(o.y) + a0[3]); w.z = pk2(bflo(o.z) + a1[0], bfhi(o.z) + a1[1]); w.w = pk2(bflo(o.w) + a1[2], bfhi(o.w) + a1[3]);
                    *(u32x4*)(H + (size_t)(row0 + ai * 128 + m * 16) * D + col0 + bj * 128) = w; }
        }
    }
};
struct EpiDft {
    static constexpr bool PERM = false, AFTER_DRAIN = false, HAS_MID = false; static constexpr int MID0 = -1, MID1 = -1;
    bf16* FO;
    __device__ __forceinline__ void mid(AccT&, const Unit&, int, int, int, int, int) const {}
    __device__ __forceinline__ void operator()(const AccT& acc, const Unit& u, int wr, int wc, int fr, int fq) const {
        const int part = u.pm >> 4, pml = u.pm & 15, b = u.pn & 7;
        const int row0 = b * 4096 + pml * 256 + wr * 64 + fr, col0 = wc * 32 + 4 * fq;
        bf16* base = FO + (size_t)part * ML * 256;
#pragma unroll
        for (int ai = 0; ai < 2; ++ai)
#pragma unroll
            for (int m = 0; m < 4; ++m) { bf16* rowp = base + (size_t)(row0 + ai * 128 + m * 16) * 256 + col0;
#pragma unroll
                for (int bj = 0; bj < 2; ++bj)
#pragma unroll
                    for (int n = 0; n < 2; ++n) { const f32x4 v = acc[ai][bj][m][n]; *(u32x2*)(rowp + bj * 128 + n * 16) = (u32x2){pg8::cvt_pk_bf16(v[0], v[1]), pg8::cvt_pk_bf16(v[2], v[3])}; } }
    }
};

__device__ __forceinline__ void phase_prologue(const Ctx& X, const Args& A) {
    LAS float* sv = (LAS float*)X.lds;
    LAS float* red = sv + 9 * 1024;
    for (int i = X.tid; i < 9 * 1024; i += NTHR) { const float v = i < 8 * 1024 ? A.in[1][i] : A.in[3][i - 8 * 1024]; sv[i] = silu_f(v); }
    __syncthreads();
    float* MOD = (float*)(X.ws + O_MOD);
    for (int it = X.bid; it < DEPTH * 24; it += X.nb) {
        const int l = it / 24, n = (it % 24) * 256 + (X.tid & 255), kh = X.tid >> 8;
        const float* w = A.in[4] + (size_t)l * D * 6144 + n;
        float acc[9];
#pragma unroll
        for (int i = 0; i < 9; ++i) acc[i] = 0.f;
        for (int k = kh * 512; k < kh * 512 + 512; ++k) { const float wv = w[(size_t)k * 6144];
#pragma unroll
            for (int i = 0; i < 9; ++i) acc[i] += sv[i * 1024 + k] * wv; }
        if (kh == 1) {
#pragma unroll
            for (int i = 0; i < 9; ++i) red[i * 256 + (X.tid & 255)] = acc[i]; }
        __syncthreads();
        if (kh == 0) { const float bv = A.in[5][(size_t)l * 6144 + n];
#pragma unroll
            for (int i = 0; i < 9; ++i) MOD[((size_t)l * 9 + i) * 6144 + n] = acc[i] + red[i * 256 + (X.tid & 255)] + bv; }
        __syncthreads();
    }
    { LAS float* ct = (LAS float*)X.lds; LAS float* st = ct + 4096;
      __syncthreads();
      for (int i = X.tid; i < 4096; i += NTHR) { float sn, cs; sincospif((float)i * (1.f / 2048.f), &sn, &cs); ct[i] = cs * (1.f / 512.f); st[i] = -sn * (1.f / 512.f); }
      __syncthreads();
      bf16* A = (bf16*)(X.ws + O_ADFT);
      const size_t total = (size_t)SEQ * SEQ / 2;
      for (size_t i = (size_t)X.bid * NTHR + X.tid; i < total; i += (size_t)X.nb * NTHR) {
          const int tp = (int)(i >> 11), t = (int)(i & 2047) * 2;
          const int p0 = (tp * t) & 4095, p1 = (p0 + tp) & 4095;
          *(unsigned*)(A + (size_t)tp * SEQ + t) = pk2(ct[p0], ct[p1]);
          *(unsigned*)(A + (size_t)SEQ * SEQ + (size_t)tp * SEQ + t) = pk2(st[p0], st[p1]); }
      __syncthreads(); }
    { u32x2* H = (u32x2*)(X.ws + O_H); const f32x4* x = (const f32x4*)A.in[0]; const f32x4* cx = (const f32x4*)A.in[2];
      const size_t nl = (size_t)ML * D / 4, nt = (size_t)MT * D / 4;
      for (size_t i = (size_t)X.bid * NTHR + X.tid; i < nt; i += (size_t)X.nb * NTHR) { const f32x4 v = i < nl ? x[i] : cx[i - nl]; H[i] = (u32x2){pk2(v.x, v.y), pk2(v.z, v.w)}; } }
}

__device__ __forceinline__ void tr_item(const float* W, int N, int k0, int n0, bf16* dst, int ld, int row0, int kdst, LAS float* scr, int lane) {
    float tv[32]; const unsigned loff = (unsigned)((lane >> 5) * N + (lane & 31));
#pragma unroll
    for (int i = 0; i < 32; ++i) { const float* rowp = W + (size_t)(k0 + 2 * i) * N + n0; tv[i] = rowp[loff]; }
#pragma unroll
    for (int i = 0; i < 32; ++i) scr[(2 * i + (lane >> 5)) * 33 + (lane & 31)] = tv[i];
    LDS_WAIT(); asm volatile("" ::: "memory");
    const int c = lane & 7;
#pragma unroll
    for (int j = 0; j < 4; ++j) { const int n = (lane >> 3) + 8 * j; const LAS float* s = scr + (8 * c) * 33 + n;
        u32x4 o; o.x = pk2(s[0 * 33], s[1 * 33]); o.y = pk2(s[2 * 33], s[3 * 33]); o.z = pk2(s[4 * 33], s[5 * 33]); o.w = pk2(s[6 * 33], s[7 * 33]);
        *(u32x4*)(dst + (size_t)(row0 + n) * ld + kdst + 8 * c) = o; }
    LDS_WAIT(); asm volatile("" ::: "memory");
}
__device__ __forceinline__ void phase_weights(const Ctx& X, const Args& A, int layer) {
    LAS float* scr = (LAS float*)(X.lds + X.wave * 8704);
    const int gw = X.bid * NWAVE + X.wave, NGW = X.nb * NWAVE;
    bf16* WIN = (bf16*)(X.ws + O_WIN); bf16* PT = (bf16*)(X.ws + O_PT); bf16* WOT = (bf16*)(X.ws + O_WOT);
    constexpr int I_WIN = 16 * 189, I_PA = 6 * 32, I_PC = 4 * 32, I_WO = 16 * 32;
    constexpr int NITEMS = I_WIN + 2 * I_PA + I_PC + I_WO;
    for (int it = gw; it < NITEMS; it += NGW) {
        int r = it;
        if (r < I_WIN) { const int kb = r / 189, nbk = r % 189, n0 = 32 * nbk;
            if (n0 < SRC_FN || n0 >= SRC_GATE) { const int d0 = n0 < 1984 ? n0 : n0 < 2048 ? n0 + 64 : n0 < 2112 ? n0 - 64 : n0 < SRC_FN ? n0 : n0 + (ZC_GATE - SRC_GATE);
                tr_item(A.in[8] + (size_t)layer * D * INCOLS, INCOLS, 64 * kb, n0, WIN, D, d0, 64 * kb, scr, X.lane); }
            continue; } r -= I_WIN;
        if (r < I_PA) { const int kb = r / 32, nbk = r % 32; tr_item(A.in[23] + (size_t)layer * RW * D, D, 64 * kb, 32 * nbk, PT, D, 32 * nbk, 64 * kb, scr, X.lane); continue; } r -= I_PA;
        if (r < I_PA) { const int kb = r / 32, nbk = r % 32; tr_item(A.in[24] + (size_t)layer * GVW * D, D, 64 * kb, 32 * nbk, PT, D, 32 * nbk, 384 + 64 * kb, scr, X.lane); continue; } r -= I_PA;
        if (r < I_PC) { const int kb = r / 32, nbk = r % 32; tr_item(A.in[25] + (size_t)layer * FNW * D, D, 64 * kb, 32 * nbk, PT, D, 32 * nbk, 768 + 64 * kb, scr, X.lane); continue; } r -= I_PC;
        { const int kb = r / 32, nbk = r % 32; tr_item(A.in[26] + (size_t)layer * D * D, D, 64 * kb, 32 * nbk, WOT, D, 32 * nbk, 64 * kb, scr, X.lane); }
    }
    { unsigned* z = (unsigned*)(WIN + (size_t)ZC_END * D); const int n = (NZ - ZC_END) * D / 2;
      for (int i = X.bid * NTHR + X.tid; i < n; i += X.nb * NTHR) z[i] = 0u; }
    { LAS float* tab = (LAS float*)(X.lds + 8 * 8704);
      if (X.tid < 64) { float sn, cs; sincospif((float)X.tid * (1.f / 32.f), &sn, &cs); tab[X.tid] = cs; tab[64 + X.tid] = sn; }
      __syncthreads();
      const float* wsrc = A.in[8] + (size_t)layer * D * INCOLS + SRC_FN;
      for (int i = X.bid * NTHR + X.tid; i < 256 * D; i += X.nb * NTHR) { const int n2 = i >> 10, k = i & 1023, g = n2 >> 6, j = n2 & 63, cp = j <= 32 ? j : j - 32;
          const float* wr = wsrc + (size_t)k * INCOLS + g * 64; const LAS float* tb = tab + (j <= 32 ? 0 : 64); float acc = 0.f;
          for (int c = 0; c < 64; c += 4) { const f32x4 wv = *(const f32x4*)(wr + c);
              acc += wv.x * tb[(c * cp) & 63] + wv.y * tb[((c + 1) * cp) & 63] + wv.z * tb[((c + 2) * cp) & 63] + wv.w * tb[((c + 3) * cp) & 63]; }
          WIN[(size_t)(ZC_FP + n2) * D + k] = (bf16)f2bf(acc); } }
    { bf16* LT = (bf16*)(X.ws + O_LORA);
      const float* wup = A.in[11] + (size_t)layer * 2 * 64 * RW; const float* aup = A.in[13] + (size_t)layer * 2 * 64 * RW;
      const float* gup = A.in[20] + (size_t)layer * 2 * 16 * GKW; const float* rgu = A.in[17] + (size_t)layer * 128 * RW;
      for (int i = X.bid * NTHR + X.tid; i < LN * LK; i += X.nb * NTHR) {
          const int n = i / LK, k = i % LK; float v = 0.f;
          if (n < 384)       { if (k < 64) v = wup[(size_t)k * RW + n]; }
          else if (n < 768)  { if (k >= 64 && k < 128) v = aup[(size_t)(k - 64) * RW + (n - 384)]; }
          else if (n < 1152) { if (k >= 128 && k < 192) v = wup[(size_t)(64 + k - 128) * RW + (n - 768)]; }
          else if (n < 1536) { if (k >= 192 && k < 256) v = aup[(size_t)(64 + k - 192) * RW + (n - 1152)]; }
          else if (n < 1728) { if (k >= 256 && k < 272) v = gup[(size_t)(k - 256) * GKW + (n - 1536)]; }
          else if (n < 1920) { if (k >= 272 && k < 288) v = gup[(size_t)(16 + k - 272) * GKW + (n - 1728)]; }
          else               { if (k >= 288 && k < 416) v = rgu[(size_t)(k - 288) * RW + (n - 1920)]; }
          LT[i] = (bf16)f2bf(v); } }
}

template <bool FINAL>
__device__ __forceinline__ void phase_norm1(const Ctx& X, const Args& A, int layer) {
    const int gw = X.bid * NWAVE + X.wave, NGW = X.nb * NWAVE;
    bf16* H = (bf16*)(X.ws + O_H); bf16* U = (bf16*)(X.ws + O_U); const float* MOD = (const float*)(X.ws + O_MOD);
    const int* SEL = (const int*)(X.ws + O_SEL); const bf16* YS = (const bf16*)(X.ws + O_XS);
    const float* nw = FINAL ? A.in[31] : A.in[6] + (size_t)layer * D;
    const int rows = FINAL ? ML : MT;
    u32x2 hw[4]; int sv = -1;
    if (gw < rows) {
#pragma unroll
        for (int j = 0; j < 4; ++j) hw[j] = *(const u32x2*)(H + (size_t)gw * D + 4 * X.lane + 256 * j);
        if (layer > 0) sv = SEL[(size_t)gw * NE + (X.lane & 15)]; }
    for (int r = gw; r < rows; r += NGW) {
        const int mi = mod_index(r);
        bf16* hr = H + (size_t)r * D + 4 * X.lane;
        f32x4 h[4];
#pragma unroll
        for (int j = 0; j < 4; ++j) h[j] = (f32x4){bflo(hw[j].x), bfhi(hw[j].x), bflo(hw[j].y), bfhi(hw[j].y)};
        const int svc = sv;
        const int rn = r + NGW;
        if (rn < rows) {
#pragma unroll
            for (int j = 0; j < 4; ++j) hw[j] = *(const u32x2*)(H + (size_t)rn * D + 4 * X.lane + 256 * j);
            if (layer > 0) sv = SEL[(size_t)rn * NE + (X.lane & 15)]; }
        if (layer > 0) {
            const float* g2 = MOD + ((size_t)(layer - 1) * 9 + mi) * 6144 + 5120 + 4 * X.lane;
            unsigned long long m = __ballot(svc >= 0) & 0xffffull;
            f32x4 a[4];
#pragma unroll
            for (int j = 0; j < 4; ++j) a[j] = (f32x4){0.f, 0.f, 0.f, 0.f};
            while (m) {
                int sl[4]; u32x2 yw[4][4];
#pragma unroll
                for (int k = 0; k < 4; ++k) { if (m) { const int e = __builtin_ctzll(m); m &= m - 1; sl[k] = __builtin_amdgcn_readlane(svc, e); } else sl[k] = -1; }
#pragma unroll
                for (int k = 0; k < 4; ++k) if (sl[k] >= 0) {
#pragma unroll
                    for (int j = 0; j < 4; ++j) yw[k][j] = *(const u32x2*)(YS + (size_t)sl[k] * D + 4 * X.lane + 256 * j); }
#pragma unroll
                for (int k = 0; k < 4; ++k) if (sl[k] >= 0) {
#pragma unroll
                    for (int j = 0; j < 4; ++j) a[j] += (f32x4){bflo(yw[k][j].x), bfhi(yw[k][j].x), bflo(yw[k][j].y), bfhi(yw[k][j].y)}; }
            }
            if (!FINAL && r >= ML && X.nb == 256) {
                const bf16* YP = (const bf16*)(X.ws + O_YP);
                unsigned long long m2 = __ballot(svc >= 0) & 0xffffull;
                while (m2) { const int e = __builtin_ctzll(m2); m2 &= m2 - 1; const int slot = __builtin_amdgcn_readlane(svc, e), prow = e * 256 + (slot - e * ME - NB * CAPL);
#pragma unroll
                    for (int p = 0; p < 3; ++p)
#pragma unroll
                        for (int j = 0; j < 4; ++j) { const u32x2 y = *(const u32x2*)(YP + (size_t)(p * 4096 + prow) * D + 4 * X.lane + 256 * j); a[j] += (f32x4){bflo(y.x), bfhi(y.x), bflo(y.y), bfhi(y.y)}; } } }
#pragma unroll
            for (int j = 0; j < 4; ++j) { const f32x4 g = *(const f32x4*)(g2 + 256 * j); h[j] = h[j] + g * a[j]; if (!FINAL) *(u32x2*)(hr + 256 * j) = (u32x2){pk2(h[j].x, h[j].y), pk2(h[j].z, h[j].w)}; }
        }
        float ss = 0.f;
#pragma unroll
        for (int j = 0; j < 4; ++j) ss += (h[j].x * h[j].x + h[j].y * h[j].y) + (h[j].z * h[j].z + h[j].w * h[j].w);
        const float rs = __builtin_amdgcn_rsqf(wave_sum_fast(ss) * (1.f / D) + NORM_EPS);
        if (FINAL) {
            float* o = X.out + (size_t)r * D + 4 * X.lane;
#pragma unroll
            for (int j = 0; j < 4; ++j) { const f32x4 w = *(const f32x4*)(nw + 4 * X.lane + 256 * j); *(f32x4*)(o + 256 * j) = h[j] * rs * w; }
        } else {
            const float* md = MOD + ((size_t)layer * 9 + mi) * 6144 + 4 * X.lane;
            bf16* ur = U + (size_t)r * D + 4 * X.lane;
#pragma unroll
            for (int j = 0; j < 4; ++j) { const f32x4 w = *(const f32x4*)(nw + 4 * X.lane + 256 * j), sh = *(const f32x4*)(md + 256 * j), sc = *(const f32x4*)(md + 1024 + 256 * j);
                const f32x4 u = h[j] * rs * w * (sc + 1.f) + sh; *(u32x2*)(ur + 256 * j) = (u32x2){pk2(u.x, u.y), pk2(u.z, u.w)}; }
        }
    }
}

__device__ __forceinline__ void conv_emit(unsigned char* ws, f32x4 a, const unsigned off, const int kind, const f32x4 kw, const float sc) {
    if (kind >= 3) a = (f32x4){silu_f(a.x), silu_f(a.y), silu_f(a.z), silu_f(a.w)} * sc;
    *(u32x2*)(ws + off) = (u32x2){pk2(a.x, a.y), pk2(a.z, a.w)};
    if (kind == 1) { const f32x4 kb = a * kw; const float ss = sum16((kb.x * kb.x + kb.y * kb.y) + (kb.z * kb.z + kb.w * kb.w));
        const float inv = __builtin_amdgcn_rsqf(fmaxf(ss, 1e-24f));
        *(u32x2*)(ws + (off + (unsigned)(O_RKK - O_KT))) = (u32x2){pk2(kb.x * inv, kb.y * inv), pk2(kb.z * inv, kb.w * inv)}; }
}
__device__ __forceinline__ f32x4 bf4(const u32x2 z) { return (f32x4){bflo(z.x), bfhi(z.x), bflo(z.y), bfhi(z.y)}; }
__device__ __forceinline__ void conv_dest(const int c, int& kind, unsigned& dst0, unsigned& stride, float& sc) {
    kind = c < ZC_K ? 0 : c < ZC_V ? 1 : c < ZC_GQ ? 2 : c < ZC_GK ? 3 : c < ZC_GV ? 4 : 5;
    dst0 = kind == 0 ? (unsigned)O_RR + 2u * c : kind == 1 ? (unsigned)O_KT + 2u * (c - ZC_K) : kind == 2 ? (unsigned)O_RV + 2u * (c - ZC_V) : kind == 3 ? (unsigned)O_GQ + 2u * (c - ZC_GQ) : kind == 4 ? (unsigned)O_GK + 2u * (c - ZC_GK) : (unsigned)O_GV + 2u * (c - ZC_GV);
    stride = (kind == 3 || kind == 4) ? 2u * GKW : 2u * RW; sc = (kind == 3) ? 0.14433756729740643f : 1.f;
}
__device__ __forceinline__ void phase_conv(const Ctx& X, const Args& A, int layer) {
    const int cm = layer & 1, lane = X.lane;
    const int gw = X.bid * NWAVE + X.wave, NGW = X.nb * NWAVE;
    const bf16* Z = (const bf16*)(X.ws + O_Z);
    const float* cwl = A.in[9] + (size_t)layer * 9 * CONVC; const float* kkw = A.in[14] + (size_t)layer * RW;
    constexpr int CONV_RB = 16, NBAND = 64 / CONV_RB, CONV_CW = 8, NSEG = 64 / CONV_CW;
    for (int it = gw; it < NB * NBAND * 8 * NSEG; it += NGW) {
        const int jj = it & 7, seg = (it >> 3) % NSEG, band = (it / (8 * NSEG)) % NBAND, b = it / (8 * NSEG * NBAND);
        const int c = 4 * lane + 256 * jj;
        if (c >= CONVC) continue;
        const int colbase = seg * CONV_CW, g0 = band * CONV_RB;
        f32x4 w[9];
#pragma unroll
        for (int tap = 0; tap < 9; ++tap) w[tap] = *(const f32x4*)(cwl + tap * CONVC + c);
        int kind; unsigned dst0, stride; float sc; conv_dest(c, kind, dst0, stride, sc);
        const unsigned step = cm ? 64u * stride : stride;
        f32x4 kw = (f32x4){0.f, 0.f, 0.f, 0.f}; if (kind == 1) kw = *(const f32x4*)(kkw + (c - ZC_K));
        u32x2 za[CONV_CW + 2], zb[CONV_CW + 2], zc[CONV_CW + 2], zd[CONV_CW + 2];
#define CONV_ROW(dst, gr_) do { const int g_ = (gr_); const bool rv_ = g_ >= 0 && g_ < 64; const bf16* zr_ = Z + ((size_t)(b * SEQ + g_ * 64 + colbase) - 1) * NZ + c; \
        _Pragma("unroll") for (int x = 0; x < CONV_CW + 2; ++x) { const int p_ = colbase + x - 1; const bool ok_ = rv_ && p_ >= 0 && p_ < 64; dst[x] = ok_ ? *(const u32x2*)(zr_ + (size_t)x * NZ) : (u32x2){0u, 0u}; } } while (0)
#define CONV_OUT(ZA, ZB, ZC, gr_) do { const int go_ = (gr_); const unsigned offb_ = dst0 + (unsigned)(cm ? b * SEQ + colbase * 64 + go_ : b * SEQ + go_ * 64 + colbase) * stride; \
        _Pragma("unroll") for (int xo = 0; xo < CONV_CW; ++xo) { f32x4 a = (f32x4){0.f, 0.f, 0.f, 0.f}; \
            _Pragma("unroll") for (int dx = 0; dx < 3; ++dx) { a += bf4(ZA[xo + dx]) * w[dx]; a += bf4(ZB[xo + dx]) * w[3 + dx]; a += bf4(ZC[xo + dx]) * w[6 + dx]; } \
            conv_emit(X.ws, a, offb_ + (unsigned)xo * step, kind, kw, sc); } } while (0)
        CONV_ROW(za, g0 - 1); CONV_ROW(zb, g0); CONV_ROW(zc, g0 + 1);
#pragma unroll 1
        for (int k = 0; k < CONV_RB; k += 4) { const int gr = g0 + k;
            CONV_ROW(zd, gr + 2); CONV_OUT(za, zb, zc, gr);
            CONV_ROW(za, gr + 3); CONV_OUT(zb, zc, zd, gr + 1);
            CONV_ROW(zb, gr + 4); CONV_OUT(zc, zd, za, gr + 2);
            CONV_ROW(zc, (k + 4 < CONV_RB) ? gr + 5 : 64); CONV_OUT(zd, za, zb, gr + 3);
        }
#undef CONV_ROW
#undef CONV_OUT
    }
    for (int it = gw; it < (MC / 64) * 8 * 4; it += NGW) {
        const int jj = it & 7, seg = (it >> 3) & 3, s2 = it >> 5;
        const int c = 4 * lane + 256 * jj;
        if (c >= CONVC) continue;
        const int colbase = seg * 16, b = s2 >> 2, sg = s2 & 3, r0 = ML + b * CTXL + sg * 64 + colbase, lo = -sg * 64, hi = CTXL - sg * 64;
        f32x4 w[3];
#pragma unroll
        for (int dx = 0; dx < 3; ++dx) w[dx] = *(const f32x4*)(cwl + (3 + dx) * CONVC + c);
        u32x2 zz[18];
#pragma unroll
        for (int x = 0; x < 18; ++x) { const int p = colbase + x - 1; const bool ok = p >= lo && p < hi; zz[x] = ok ? *(const u32x2*)(Z + (size_t)(r0 + x - 1) * NZ + c) : (u32x2){0u, 0u}; }
        int kind; unsigned dst0, stride; float sc; conv_dest(c, kind, dst0, stride, sc);
        f32x4 kw = (f32x4){0.f, 0.f, 0.f, 0.f}; if (kind == 1) kw = *(const f32x4*)(kkw + (c - ZC_K));
        const unsigned offb = dst0 + (unsigned)r0 * stride;
#pragma unroll
        for (int xo = 0; xo < 16; ++xo) {
            f32x4 a = (f32x4){0.f, 0.f, 0.f, 0.f};
#pragma unroll
            for (int dx = 0; dx < 3; ++dx) a += bf4(zz[xo + dx]) * w[dx];
            conv_emit(X.ws, a, offb + (unsigned)xo * stride, kind, kw, sc); }
    }
}

__device__ __forceinline__ int chain_row(int dir, int b, int s) {
    if (s < CTXL) return ML + b * CTXL + (dir ? (CTXL - 1 - s) : s);
    const int p = s - CTXL; return b * SEQ + (dir ? (SEQ - 1 - p) : p);
}
constexpr int WEXP_ITEMS = 3 * 1024 * NE;
struct WexpLoc { const float* W; bf16* dst; int N, k0, n0, ld, row0; };
__device__ __forceinline__ WexpLoc wexp_locate(const Ctx& X, const Args& A, int layer, int r) {
    WexpLoc L; constexpr int I_E = 1024 * NE;
    if (r < 2 * I_E) { const int which = r / I_E; r -= which * I_E; const int e = r >> 10, q = r & 1023, kb = q >> 6, nbk = q & 63, n0 = 32 * nbk;
        L.W = A.in[which ? 29 : 28] + ((size_t)layer * NE + e) * D * EH; L.N = EH; L.k0 = 64 * kb; L.n0 = n0; L.dst = (bf16*)(X.ws + O_W13) + (size_t)e * 4096 * D; L.ld = D; L.row0 = (n0 >> 7) * 256 + (n0 & 127) + which * 128; }
    else { r -= 2 * I_E; const int e = r >> 10, q = r & 1023, kb = q >> 5, nbk = q & 31;
        L.W = A.in[30] + ((size_t)layer * NE + e) * EH * D; L.N = D; L.k0 = 64 * kb; L.n0 = 32 * nbk; L.dst = (bf16*)(X.ws + O_W2T) + (size_t)e * D * EH; L.ld = EH; L.row0 = 32 * nbk; }
    return L;
}
__device__ __forceinline__ void wexp_issue(const WexpLoc& L, int lane, float (&tv)[32]) {
    const unsigned loff = (unsigned)((lane >> 5) * L.N + (lane & 31));
#pragma unroll
    for (int i = 0; i < 32; ++i) { const float* rowp = L.W + (size_t)(L.k0 + 2 * i) * L.N + L.n0; tv[i] = rowp[loff]; }
}
__device__ __forceinline__ void wexp_finish(const WexpLoc& L, int lane, const float (&tv)[32], LAS float* scr) {
#pragma unroll
    for (int i = 0; i < 32; ++i) scr[(2 * i + (lane >> 5)) * 33 + (lane & 31)] = tv[i];
    LDS_WAIT(); asm volatile("" ::: "memory");
    const int c = lane & 7;
#pragma unroll
    for (int j = 0; j < 4; ++j) { const int n = (lane >> 3) + 8 * j; const LAS float* sp = scr + (8 * c) * 33 + n;
        u32x4 o; o.x = pk2(sp[0 * 33], sp[1 * 33]); o.y = pk2(sp[2 * 33], sp[3 * 33]); o.z = pk2(sp[4 * 33], sp[5 * 33]); o.w = pk2(sp[6 * 33], sp[7 * 33]);
        *(u32x4*)(L.dst + (size_t)(L.row0 + n) * L.ld + L.k0 + 8 * c) = o; }
    LDS_WAIT(); asm volatile("" ::: "memory");
}
__device__ __forceinline__ void wexp_rest(const Ctx& X, const Args& A, int layer, int first, int stride) {
    LAS float* scr = (LAS float*)(X.lds + X.wave * 8704);
    for (int r = first; r < WEXP_ITEMS; r += stride) { float tv[32]; const WexpLoc L = wexp_locate(X, A, layer, r); wexp_issue(L, X.lane, tv); wexp_finish(L, X.lane, tv, scr); }
}

typedef short bf16x8 __attribute__((ext_vector_type(8)));
typedef float f32x16 __attribute__((ext_vector_type(16)));
__device__ __forceinline__ f32x16 mm32(const LAS bf16* A, int lda, const LAS bf16* Bt, int ldb, int ksteps, f32x16 acc, int lane) {
    const LAS bf16* pa = A + (lane & 31) * lda + 8 * (lane >> 5); const LAS bf16* pb = Bt + (lane & 31) * ldb + 8 * (lane >> 5);
    for (int st = 0; st < ksteps; ++st) { const bf16x8 a = *(const LAS bf16x8*)(pa + 16 * st), bq = *(const LAS bf16x8*)(pb + 16 * st); acc = __builtin_amdgcn_mfma_f32_32x32x16_bf16(a, bq, acc, 0, 0, 0); }
    return acc;
}
#define CROW(reg, lane) (((reg) & 3) + 8 * ((reg) >> 2) + 4 * ((lane) >> 5))
__device__ __forceinline__ f32x16 zero16() { f32x16 z;
#pragma unroll
    for (int i = 0; i < 16; ++i) z[i] = 0.f; return z; }
__device__ __forceinline__ void st_rowmajor(const f32x16& c, LAS bf16* dst, int ld, int lane) {
#pragma unroll
    for (int i = 0; i < 16; ++i) dst[CROW(i, lane) * ld + (lane & 31)] = (bf16)f2bf(c[i]);
}
__device__ __forceinline__ void st_transposed(const f32x16& c, LAS bf16* dst, int ld, int lane) {
#pragma unroll
    for (int g = 0; g < 4; ++g) *(LAS u32x2*)(dst + (lane & 31) * ld + 8 * g + 4 * (lane >> 5)) = (u32x2){pk2(c[4 * g], c[4 * g + 1]), pk2(c[4 * g + 2], c[4 * g + 3])};
}
__device__ __forceinline__ f32x16 mm32_regB(const LAS bf16* A, int lda, const f32x16& Xt, f32x16 acc, int lane) {
    const LAS bf16* pa = A + (lane & 31) * lda + 4 * (lane >> 5);
#pragma unroll
    for (int st = 0; st < 2; ++st) {
        const u32x4 bp = (u32x4){pk2(Xt[8 * st], Xt[8 * st + 1]), pk2(Xt[8 * st + 2], Xt[8 * st + 3]), pk2(Xt[8 * st + 4], Xt[8 * st + 5]), pk2(Xt[8 * st + 6], Xt[8 * st + 7])};
        const u32x2 a0 = *(const LAS u32x2*)(pa + 16 * st), a1 = *(const LAS u32x2*)(pa + 16 * st + 8);
        const u32x4 ap = (u32x4){a0.x, a0.y, a1.x, a1.y};
        acc = __builtin_amdgcn_mfma_f32_32x32x16_bf16(__builtin_bit_cast(bf16x8, ap), __builtin_bit_cast(bf16x8, bp), acc, 0, 0, 0); }
    return acc;
}
#define BLK_BAR() do { asm volatile("s_waitcnt lgkmcnt(0)" ::: "memory"); __builtin_amdgcn_s_barrier(); asm volatile("" ::: "memory"); } while (0)

__device__ __forceinline__ void scan_rwkv(const Ctx& X, const Args& A, int layer, int chain) {
    const int wave = X.wave, tid0 = X.tid;
    const int dir = chain / 48, b = (chain % 48) / 6, h = chain % 6;
    constexpr int LT = 72;
    LAS unsigned char* L0 = X.lds;
    LAS bf16* AR = (LAS bf16*)L0;
    LAS bf16* BK = (LAS bf16*)(L0 + 18432); LAS bf16* R2T = BK;
    LAS bf16* AT = (LAS bf16*)(L0 + 36864); LAS bf16* BT = AT + 64 * LT; LAS bf16* KT2 = BT + 64 * LT; LAS bf16* VT = KT2 + 64 * LT;
    LAS bf16* MAB = (LAS bf16*)(L0 + 73728); LAS bf16* MAK = MAB + 64 * LT; LAS bf16* MRB = MAK + 64 * LT; LAS bf16* MRK = MRB + 64 * LT; LAS bf16* PL = MAB;
    LAS float* DF = (LAS float*)(L0 + 110592);
    LAS bf16* TP0T = (LAS bf16*)(L0 + 118784); LAS bf16* WT = TP0T + 2 * 1280;
    LAS float* LS = (LAS float*)(L0 + 126976); LAS float* WC = (LAS float*)(L0 + 131072);
    LAS bf16* XYT = (LAS bf16*)(L0 + 110592);
    LAS bf16* SBb = (LAS bf16*)(L0 + 131328);
    LAS bf16* TB = (LAS bf16*)(L0 + 149760);
    const bf16* RR = (const bf16*)(X.ws + O_RR); const bf16* RV = (const bf16*)(X.ws + O_RV); const bf16* RKK = (const bf16*)(X.ws + O_RKK);
    const bf16* KTg = (const bf16*)(X.ws + O_KT); const bf16* LO = (const bf16*)(X.ws + O_LO) + dir * 768 + h * 64; float* BS = (float*)(X.ws + O_BS) + (size_t)dir * MT * 6 + h;
    bf16* ORW = (bf16*)(X.ws + O_ORW) + (size_t)dir * MT * RW; const int cm = layer & 1;
    const float* Pw0 = A.in[10] + (size_t)layer * 768 + dir * 384 + h * 64; const float* Pa0 = A.in[12] + (size_t)layer * 768 + dir * 384 + h * 64; const float* Pka = A.in[15] + (size_t)layer * 384 + h * 64; const float* Prk = A.in[16] + (size_t)layer * 384 + h * 64;
    __syncthreads();
    for (int i = X.tid; i < 158976 / 4; i += NTHR) ((LAS unsigned*)L0)[i] = 0u;
    __syncthreads();
    unsigned pr[4], pkk[4], pkt[4], pwp[4], pap[4]; unsigned pv[4];
#define RC_FETCH(ck_) do { \
        _Pragma("unroll") for (int i = 0; i < 4; ++i) { const int q_ = chain_row(dir, b, (ck_) * 64 + 4 * tg + i); const unsigned off_ = (unsigned)q_ * (unsigned)RW + (unsigned)(h * 64 + 2 * kp), lof_ = (unsigned)scan_row(q_, cm) * (unsigned)LN + (unsigned)(2 * kp); \
            pr[i] = *(const unsigned*)(RR + off_); pkk[i] = *(const unsigned*)(RKK + off_); pkt[i] = *(const unsigned*)(KTg + off_); pwp[i] = *(const unsigned*)(LO + lof_); pap[i] = *(const unsigned*)(LO + lof_ + 384); } \
        _Pragma("unroll") for (int i = 0; i < 4; ++i) pv[i] = *(const unsigned*)(RV + ((unsigned)chain_row(dir, b, (ck_) * 64 + 4 * tgv + i) * (unsigned)RW + (unsigned)(h * 64 + 2 * vq))); } while (0)
    { const int kp = tid0 & 31, tg = tid0 >> 5, vq = tid0 & 31, tgv = tid0 >> 5; RC_FETCH(0); }
    for (int ck = 0; ck < (CTXL + SEQ) / 64; ++ck) {
        int td = tid0; asm volatile("" : "+v"(td));
        const int lane = td & 63, kp = td & 31, tg = td >> 5, vq = td & 31, tgv = td >> 5;
        LAS bf16* SBc = SBb + (ck & 1) * 64 * LT; LAS bf16* SBn = SBb + ((ck + 1) & 1) * 64 * LT;
        float c0[4], c1[4], ldx[4], ldy[4], kmx[4], kmy[4], bbx[4], bby[4];
        { const f32x2 w0v = *(const f32x2*)(Pw0 + 2 * kp), a0v = *(const f32x2*)(Pa0 + 2 * kp), kav = *(const f32x2*)(Pka + 2 * kp), rkv = *(const f32x2*)(Prk + 2 * kp);
          float a0 = 0.f, a1 = 0.f;
#pragma unroll
          for (int i = 0; i < 4; ++i) {
              ldx[i] = -0.6065306597f * sigmoid_f(w0v.x + bflo(pwp[i])); ldy[i] = -0.6065306597f * sigmoid_f(w0v.y + bfhi(pwp[i]));
              const float av0 = sigmoid_f(a0v.x + bflo(pap[i])), av1 = sigmoid_f(a0v.y + bfhi(pap[i]));
              kmx[i] = bflo(pkt[i]) * (1.f + (av0 - 1.f) * kav.x); kmy[i] = bfhi(pkt[i]) * (1.f + (av1 - 1.f) * kav.y); bbx[i] = bflo(pkk[i]) * av0; bby[i] = bfhi(pkk[i]) * av1;
              { const float bsum = half_sum_fast(bflo(pr[i]) * kmx[i] * rkv.x + bfhi(pr[i]) * kmy[i] * rkv.y);
                  if (kp == 0) BS[(size_t)chain_row(dir, b, ck * 64 + 4 * tg + i) * 6] = bsum; }
              a0 += ldx[i]; a1 += ldy[i]; c0[i] = a0; c1[i] = a1; }
          *(LAS f32x2*)(LS + tg * 64 + 2 * kp) = (f32x2){a0, a1}; }
        *(LAS u32x2*)(VT + (2 * vq) * LT + 4 * tgv) = (u32x2){(pv[0] & 0xffffu) | (pv[1] << 16), (pv[2] & 0xffffu) | (pv[3] << 16)};
        *(LAS u32x2*)(VT + (2 * vq + 1) * LT + 4 * tgv) = (u32x2){(pv[0] >> 16) | (pv[1] & 0xffff0000u), (pv[2] >> 16) | (pv[3] & 0xffff0000u)};
        BLK_BAR();
        { float o0 = 0.f, o1 = 0.f, t0 = 0.f, t1 = 0.f;
#pragma unroll
          for (int g = 0; g < 16; ++g) { const f32x2 gs = *(const LAS f32x2*)(LS + g * 64 + 2 * kp); o0 += (g < tg) ? gs.x : 0.f; o1 += (g < tg) ? gs.y : 0.f; t0 += gs.x; t1 += gs.y; }
          unsigned ta0[4], ta1[4], tb0[4], tb1[4], tk0[4], tk1[4];
          float pe0 = __expf(o0), pe1 = __expf(o1);
#pragma unroll
          for (int i = 0; i < 4; ++i) { const int t = 4 * tg + i; const float l0 = c0[i] + o0, l1 = c1[i] + o1;
              const float e0 = __expf(l0), e1 = __expf(l1), n0 = __builtin_amdgcn_rcpf(e0), n1 = __builtin_amdgcn_rcpf(e1), p0 = pe0, p1 = pe1; pe0 = e0; pe1 = e1;
              ta0[i] = f2bf(bflo(pkk[i]) * p0); ta1[i] = f2bf(bfhi(pkk[i]) * p1); tb0[i] = f2bf(bbx[i] * n0); tb1[i] = f2bf(bby[i] * n1); tk0[i] = f2bf(kmx[i] * n0); tk1[i] = f2bf(kmy[i] * n1);
              *(LAS unsigned*)(AR + t * LT + 2 * kp) = ta0[i] | (ta1[i] << 16); *(LAS unsigned*)(AR + (64 + t) * LT + 2 * kp) = pk2(bflo(pr[i]) * e0, bfhi(pr[i]) * e1);
              *(LAS unsigned*)(BK + t * LT + 2 * kp) = tb0[i] | (tb1[i] << 16); *(LAS unsigned*)(BK + (64 + t) * LT + 2 * kp) = tk0[i] | (tk1[i] << 16); }
          *(LAS u32x2*)(AT + (2 * kp) * LT + 4 * tg) = (u32x2){ta0[0] | (ta0[1] << 16), ta0[2] | (ta0[3] << 16)}; *(LAS u32x2*)(AT + (2 * kp + 1) * LT + 4 * tg) = (u32x2){ta1[0] | (ta1[1] << 16), ta1[2] | (ta1[3] << 16)};
          *(LAS u32x2*)(BT + (2 * kp) * LT + 4 * tg) = (u32x2){tb0[0] | (tb0[1] << 16), tb0[2] | (tb0[3] << 16)}; *(LAS u32x2*)(BT + (2 * kp + 1) * LT + 4 * tg) = (u32x2){tb1[0] | (tb1[1] << 16), tb1[2] | (tb1[3] << 16)};
          *(LAS u32x2*)(KT2 + (2 * kp) * LT + 4 * tg) = (u32x2){tk0[0] | (tk0[1] << 16), tk0[2] | (tk0[3] << 16)}; *(LAS u32x2*)(KT2 + (2 * kp + 1) * LT + 4 * tg) = (u32x2){tk1[0] | (tk1[1] << 16), tk1[2] | (tk1[3] << 16)};
          if (tg == 0) *(LAS f32x2*)(WC + 2 * kp) = (f32x2){__expf(t0), __expf(t1)}; }
        if (ck + 1 < (CTXL + SEQ) / 64) RC_FETCH(ck + 1);
        BLK_BAR();
        if (wave < 2) { const int p = wave; LAS bf16* TDT = TP0T + p * 1280; LAS bf16* WTp = p ? (LAS bf16*)LS : TP0T + 2560;
            { f32x16 c = mm32(AR + 32 * p * LT, LT, BK + 32 * p * LT, LT, 4, zero16(), lane);
#pragma unroll
              for (int i = 0; i < 16; ++i) if ((lane & 31) >= CROW(i, lane)) c[i] = 0.f;
              st_rowmajor(c, MAB + 32 * p * LT + 32 * p, LT, lane);
#pragma unroll
              for (int i = 0; i < 16; ++i) DF[p * 1024 + CROW(i, lane) * 32 + (lane & 31)] = c[i]; }
            asm volatile("s_waitcnt lgkmcnt(0)" ::: "memory");
            const int bl = (lane >> 4) & 1, cc = lane & 15; const LAS float* Ablk = DF + p * 1024 + (16 * bl) * 32 + 16 * bl;
            float x[16];
#pragma unroll
            for (int i = 0; i < 16; ++i) x[i] = (i == cc) ? 1.f : 0.f;
#pragma unroll
            for (int j = 0; j < 15; ++j) {
#pragma unroll
                for (int i = j + 1; i < 16; ++i) x[i] -= Ablk[i * 32 + j] * x[j]; }
            if (lane < 32) {
#pragma unroll
                for (int i = 0; i < 16; ++i) { TB[(32 * p + 16 * bl + i) * LT + 32 * p + 16 * bl + cc] = (bf16)f2bf(x[i]); TB[(32 * p + 16 * bl + i) * LT + 32 * p + 16 * (1 - bl) + cc] = 0; }
                u32x4 lo, hi; lo.x = pk2(x[0], x[1]); lo.y = pk2(x[2], x[3]); lo.z = pk2(x[4], x[5]); lo.w = pk2(x[6], x[7]); hi.x = pk2(x[8], x[9]); hi.y = pk2(x[10], x[11]); hi.z = pk2(x[12], x[13]); hi.w = pk2(x[14], x[15]);
                LAS bf16* d = TDT + (16 * bl + cc) * 40; *(LAS u32x4*)(d + 16 * bl) = lo; *(LAS u32x4*)(d + 16 * bl + 8) = hi;
                const u32x4 z = (u32x4){0u, 0u, 0u, 0u}; *(LAS u32x4*)(d + 16 * (1 - bl)) = z; *(LAS u32x4*)(d + 16 * (1 - bl) + 8) = z; }
            asm volatile("s_waitcnt lgkmcnt(0)" ::: "memory");
            const f32x16 w2 = mm32(MAB + 32 * p * LT + 32 * p, LT, TDT, 40, 2, zero16(), lane); st_transposed(w2, WTp, 40, lane);
            asm volatile("s_waitcnt lgkmcnt(0)" ::: "memory");
            const f32x16 c2 = mm32(TB + 32 * p * LT + 32 * p, LT, WTp, 40, 2, zero16(), lane);
            if ((lane & 31) < 16) {
#pragma unroll
                for (int i = 8; i < 16; ++i) TB[(32 * p + CROW(i, lane)) * LT + 32 * p + (lane & 31)] = (bf16)f2bf(-c2[i]);
                if (p == 0) { LAS bf16* d = TDT + (lane & 31) * 40 + 16 + 4 * (lane >> 5);
                    *(LAS u32x2*)(d) = (u32x2){pk2(-c2[8], -c2[9]), pk2(-c2[10], -c2[11])}; *(LAS u32x2*)(d + 8) = (u32x2){pk2(-c2[12], -c2[13]), pk2(-c2[14], -c2[15])}; } }
        } else if (wave < 7) {
#pragma unroll
            for (int s2 = 0; s2 < 2; ++s2) { const int tl = (wave - 2) * 2 + s2;
                const int qd = tl == 0 ? 0 : tl < 4 ? 1 : tl < 7 ? 2 : 3;
                const int ti = (tl == 1 || tl == 4 || tl == 8) ? 0 : 1, tj = (tl == 3 || tl == 5 || tl == 9) ? 1 : 0;
                f32x16 c = mm32(AR + ((qd >> 1) * 64 + 32 * ti) * LT, LT, BK + ((qd & 1) * 64 + 32 * tj) * LT, LT, 4, zero16(), lane);
                if (ti == tj) { const int strict = (qd < 2) ? 1 : 0;
#pragma unroll
                    for (int i = 0; i < 16; ++i) if ((lane & 31) + strict > CROW(i, lane)) c[i] = 0.f; }
                st_rowmajor(c, MAB + qd * 64 * LT + 32 * ti * LT + 32 * tj, LT, lane); }
        } else {
#pragma unroll
            for (int e = 0; e < 16; ++e) { const int idx = lane * 16 + e; TB[(idx >> 5) * LT + 32 + (idx & 31)] = 0; } }
        BLK_BAR();
        if (wave == 0) { const f32x16 w3 = mm32(MAB + 32 * LT, LT, TP0T, 40, 2, zero16(), lane); st_transposed(w3, WT, 40, lane);
            asm volatile("s_waitcnt lgkmcnt(0)" ::: "memory");
            f32x16 tl = mm32(TB + 32 * LT + 32, LT, WT, 40, 2, zero16(), lane);
#pragma unroll
            for (int i = 0; i < 16; ++i) tl[i] = -tl[i];
            st_rowmajor(tl, TB + 32 * LT, LT, lane);
        } else if (wave >= 4) { const int ti = wave & 1, vh = (wave - 4) >> 1;
            const f32x16 c = mm32(MAK + 32 * ti * LT, LT, VT + 32 * vh * LT, LT, ti ? 4 : 2, zero16(), lane); st_transposed(c, R2T + 32 * vh * LT + 32 * ti, LT, lane); }
        BLK_BAR();
        f32x16 qt = zero16();
        if (wave < 4) { const int ti = wave >> 1, kj = wave & 1;
            const f32x16 x0 = mm32(TB, LT, AT + 32 * kj * LT, LT, 2, zero16(), lane);
            f32x16 c = mm32_regB(MRB + 32 * ti * LT, LT, x0, zero16(), lane);
            if (ti) { const f32x16 x1 = mm32(TB + 32 * LT, LT, AT + 32 * kj * LT, LT, 4, zero16(), lane);
                c = mm32_regB(MRB + 32 * LT + 32, LT, x1, c, lane);
                st_transposed(x0, XYT + 32 * kj * LT, LT, lane); st_transposed(x1, XYT + 32 * kj * LT + 32, LT, lane); }
#pragma unroll
            for (int i = 0; i < 16; ++i) c[i] = bf1(AR[(64 + 32 * ti + CROW(i, lane)) * LT + 32 * kj + (lane & 31)]) - c[i];
            st_rowmajor(c, PL + 32 * ti * LT + 32 * kj, LT, lane);
        } else { const int ti = wave & 1, vh = (wave - 4) >> 1;
            const f32x16 y0 = mm32(TB, LT, R2T + 32 * vh * LT, LT, 2, zero16(), lane);
            f32x16 qn = mm32_regB(MRB + 32 * ti * LT, LT, y0, zero16(), lane);
            if (ti) { const f32x16 y1 = mm32(TB + 32 * LT, LT, R2T + 32 * vh * LT, LT, 4, zero16(), lane);
                qn = mm32_regB(MRB + 32 * LT + 32, LT, y1, qn, lane);
                st_transposed(y0, XYT + (64 + 32 * vh) * LT, LT, lane); st_transposed(y1, XYT + (64 + 32 * vh) * LT + 32, LT, lane); }
            qt = mm32(MRK + 32 * ti * LT, LT, VT + 32 * vh * LT, LT, ti ? 4 : 2, zero16(), lane);
#pragma unroll
            for (int i = 0; i < 16; ++i) qt[i] -= qn[i]; }
        BLK_BAR();
        if (wave >= 4) { const int ti = wave & 1, vh = (wave - 4) >> 1;
            const f32x16 o = mm32(PL + 32 * ti * LT, LT, SBc + 32 * vh * LT, LT, 4, qt, lane);
#pragma unroll
            for (int i = 0; i < 16; ++i) ORW[(unsigned)chain_row(dir, b, ck * 64 + 32 * ti + CROW(i, lane)) * (unsigned)RW + (unsigned)(h * 64 + 32 * vh + (lane & 31))] = (bf16)f2bf(o[i]);
        } else { const int kj = wave & 1, vh = wave >> 1; const float wc = WC[32 * kj + (lane & 31)];
            f32x16 nt = mm32(VT + 32 * vh * LT, LT, KT2 + 32 * kj * LT, LT, 4, zero16(), lane);
            const f32x16 nn = mm32(XYT + (64 + 32 * vh) * LT, LT, BT + 32 * kj * LT, LT, 4, zero16(), lane);
#pragma unroll
            for (int i = 0; i < 16; ++i) nt[i] = (nt[i] - nn[i]) * wc;
#pragma unroll
            for (int ki = 0; ki < 2; ++ki) { f32x16 g = mm32(XYT + 32 * ki * LT, LT, BT + 32 * kj * LT, LT, 4, zero16(), lane);
#pragma unroll
                for (int i = 0; i < 16; ++i) g[i] = (((32 * ki + CROW(i, lane)) == (32 * kj + (lane & 31)) ? 1.f : 0.f) - g[i]) * wc;
                nt = mm32_regB(SBc + 32 * vh * LT + 32 * ki, LT, g, nt, lane); }
            st_rowmajor(nt, SBn + 32 * vh * LT + 32 * kj, LT, lane); }
        BLK_BAR();
    }
#undef RC_FETCH
    __syncthreads();
}
__device__ __forceinline__ void scan_gla(const Ctx& X, const Args& A, int layer, int chain) {
    const int dir = chain / 32, b = (chain % 32) / 4, h = chain % 4, lane = X.lane, wave = X.wave;
    constexpr int LQ = 56, LT = 72;
    LAS bf16* QI = (LAS bf16*)X.lds; LAS bf16* KI = QI + 64 * LQ; LAS bf16* KTt = KI + 64 * LQ; LAS bf16* VT = KTt + 64 * LT; LAS bf16* ATT = VT + 96 * LT; LAS bf16* ST = ATT + 64 * LT;
    LAS float* gsum = (LAS float*)(ST + 96 * LQ); LAS float* dec = gsum + 16 * 48;
    const bf16* GQ = (const bf16*)(X.ws + O_GQ); const bf16* GK = (const bf16*)(X.ws + O_GK); const bf16* GV = (const bf16*)(X.ws + O_GV);
    const bf16* LOg = (const bf16*)(X.ws + O_LO) + 1536 + dir * 192 + h * 48; const float* Pab = A.in[21] + (size_t)layer * 384 + dir * 192 + h * 48; const int cm = layer & 1;
    bf16* OGL = (bf16*)(X.ws + O_OGL) + (size_t)dir * MT * GVW;
    __syncthreads();
    for (int i = X.tid; i < (64 * LQ * 2 + 64 * LT + 96 * LT + 64 * LT + 96 * LQ) / 2; i += NTHR) ((LAS unsigned*)QI)[i] = 0u;
    if (X.tid < 64) dec[X.tid] = 0.f;
    __syncthreads();
    const int kp = X.tid & 31, tg = X.tid >> 5;
    const int vp = X.tid & 63, tg8 = X.tid >> 6;
    unsigned pq[4], pk[4], pg[4]; unsigned pv[8];
#define GC_FETCH(ck_) do { \
        if (kp < 24) { _Pragma("unroll") for (int i = 0; i < 4; ++i) { const int q_ = chain_row(dir, b, (ck_) * 64 + 4 * tg + i); const unsigned off_ = (unsigned)q_ * (unsigned)GKW + (unsigned)(h * 48 + 2 * kp); \
            pq[i] = *(const unsigned*)(GQ + off_); pk[i] = *(const unsigned*)(GK + off_); pg[i] = *(const unsigned*)(LOg + ((unsigned)scan_row(q_, cm) * (unsigned)LN + (unsigned)(2 * kp))); } } \
        if (vp < 48) { _Pragma("unroll") for (int i = 0; i < 8; ++i) pv[i] = *(const unsigned*)(GV + ((unsigned)chain_row(dir, b, (ck_) * 64 + 8 * tg8 + i) * (unsigned)GVW + (unsigned)(h * 96 + 2 * vp))); } } while (0)
    GC_FETCH(0);
    f32x16 S = zero16();
    const int smi = wave / 3, sni = wave % 3;
    for (int ck = 0; ck < (CTXL + SEQ) / 64; ++ck) {
        float g0[4], g1[4];
        if (kp < 24) { float a0 = 0.f, a1 = 0.f; const f32x2 abv = *(const f32x2*)(Pab + 2 * kp);
#pragma unroll
            for (int i = 0; i < 4; ++i) { a0 += logsigmoid_f(bflo(pg[i]) + abv.x) * (1.f / 16.f); a1 += logsigmoid_f(bfhi(pg[i]) + abv.y) * (1.f / 16.f); g0[i] = a0; g1[i] = a1; }
            *(LAS f32x2*)(gsum + tg * 48 + 2 * kp) = (f32x2){a0, a1}; }
        if (vp < 48) {
            u32x4 lo, hi;
            lo.x = (pv[0] & 0xffffu) | (pv[1] << 16); lo.y = (pv[2] & 0xffffu) | (pv[3] << 16); lo.z = (pv[4] & 0xffffu) | (pv[5] << 16); lo.w = (pv[6] & 0xffffu) | (pv[7] << 16);
            hi.x = (pv[0] >> 16) | (pv[1] & 0xffff0000u); hi.y = (pv[2] >> 16) | (pv[3] & 0xffff0000u); hi.z = (pv[4] >> 16) | (pv[5] & 0xffff0000u); hi.w = (pv[6] >> 16) | (pv[7] & 0xffff0000u);
            *(LAS u32x4*)(VT + (2 * vp) * LT + 8 * tg8) = lo; *(LAS u32x4*)(VT + (2 * vp + 1) * LT + 8 * tg8) = hi; }
        BLK_BAR();
        if (kp < 24) { float o0 = 0.f, o1 = 0.f, t0 = 0.f, t1 = 0.f;
#pragma unroll
            for (int g = 0; g < 16; ++g) { const f32x2 gs = *(const LAS f32x2*)(gsum + g * 48 + 2 * kp); o0 += (g < tg) ? gs.x : 0.f; o1 += (g < tg) ? gs.y : 0.f; t0 += gs.x; t1 += gs.y; }
            unsigned kt0[4], kt1[4]; const float et0 = __expf(t0), et1 = __expf(t1);
#pragma unroll
            for (int i = 0; i < 4; ++i) { const float c0 = g0[i] + o0, c1 = g1[i] + o1; const int t = 4 * tg + i;
                const float e0 = __expf(c0), e1 = __expf(c1), n0 = __builtin_amdgcn_rcpf(e0), n1 = __builtin_amdgcn_rcpf(e1), l0 = et0 * n0, l1 = et1 * n1;
                const float q0 = bflo(pq[i]), q1 = bfhi(pq[i]), k0 = bflo(pk[i]), k1 = bfhi(pk[i]);
                *(LAS unsigned*)(QI + t * LQ + 2 * kp) = pk2(q0 * e0, q1 * e1); *(LAS unsigned*)(KI + t * LQ + 2 * kp) = pk2(k0 * n0, k1 * n1);
                kt0[i] = f2bf(k0 * l0); kt1[i] = f2bf(k1 * l1); }
            *(LAS u32x2*)(KTt + (2 * kp) * LT + 4 * tg) = (u32x2){kt0[0] | (kt0[1] << 16), kt0[2] | (kt0[3] << 16)};
            *(LAS u32x2*)(KTt + (2 * kp + 1) * LT + 4 * tg) = (u32x2){kt1[0] | (kt1[1] << 16), kt1[2] | (kt1[3] << 16)};
            if (tg == 0) *(LAS f32x2*)(dec + 2 * kp) = (f32x2){et0, et1}; }
        if (ck + 1 < (CTXL + SEQ) / 64) GC_FETCH(ck + 1);
        BLK_BAR();
        f32x16 kv = zero16();
        if (wave < 6) kv = mm32(KTt + 32 * smi * LT, LT, VT + 32 * sni * LT, LT, 4, kv, lane);
        else if (wave == 6) {
#pragma unroll
            for (int d = 0; d < 2; ++d) { f32x16 c = mm32(QI + 32 * d * LQ, LQ, KI + 32 * d * LQ, LQ, 3, zero16(), lane);
#pragma unroll
                for (int i = 0; i < 16; ++i) if ((lane & 31) > CROW(i, lane)) c[i] = 0.f;
                st_rowmajor(c, ATT + 32 * d * LT + 32 * d, LT, lane); }
        } else { const f32x16 c = mm32(QI + 32 * LQ, LQ, KI, LQ, 3, zero16(), lane); st_rowmajor(c, ATT + 32 * LT, LT, lane); }
        BLK_BAR();
        if (wave < 6) { f32x16 o = mm32(ATT + 32 * smi * LT, LT, VT + 32 * sni * LT, LT, smi ? 4 : 2, zero16(), lane);
            o = mm32(QI + 32 * smi * LQ, LQ, ST + 32 * sni * LQ, LQ, 3, o, lane);
#pragma unroll
            for (int i = 0; i < 16; ++i) OGL[(unsigned)chain_row(dir, b, ck * 64 + 32 * smi + CROW(i, lane)) * (unsigned)GVW + (unsigned)(h * 96 + 32 * sni + (lane & 31))] = (bf16)f2bf(o[i]); }
        BLK_BAR();
        if (wave < 6) {
#pragma unroll
            for (int i = 0; i < 16; ++i) S[i] = S[i] * dec[32 * smi + CROW(i, lane)] + kv[i];
            if (smi == 0) st_transposed(S, ST + 32 * sni * LQ, LQ, lane);
            else {
#pragma unroll
                for (int g = 0; g < 2; ++g) *(LAS u32x2*)(ST + (32 * sni + (lane & 31)) * LQ + 32 + 8 * g + 4 * (lane >> 5)) = (u32x2){pk2(S[4 * g], S[4 * g + 1]), pk2(S[4 * g + 2], S[4 * g + 3])}; }
        }
        BLK_BAR();
    }
#undef GC_FETCH
    __syncthreads();
}
__device__ __forceinline__ void ctx_dft(const Ctx& X, int item) {
    LAS float* tab = (LAS float*)X.lds;
    __syncthreads();
    if (X.tid < 256) { float s, c; sincospif((float)X.tid * (1.f / 128.f), &s, &c); tab[X.tid] = c; tab[256 + X.tid] = s; }
    __syncthreads();
    const int b = item >> 4, tp0 = (item & 15) * 16 + (X.tid >> 8) * 8, n = X.tid & 255;
    const int g = n >> 6, cp = n & 63, cf = cp <= 32 ? cp : 64 - cp;
    const float sgn = (cp == 0 || cp == 32) ? 0.f : (cp < 32 ? 1.f : -1.f);
    const bf16* ZG = (const bf16*)(X.ws + O_Z) + (size_t)(ML + b * CTXL) * NZ + ZC_FP + g * 64; float* FOC = (float*)(X.ws + O_FOC);
    const int cs_col = (cp == 0 || cp == 32) ? cf : 32 + cf;
    float acc[8];
#pragma unroll
    for (int i = 0; i < 8; ++i) acc[i] = 0.f;
    for (int t = 0; t < CTXL; ++t) { const float gc = bf1(ZG[(size_t)t * NZ + cf]), gs = sgn * bf1(ZG[(size_t)t * NZ + cs_col]);
#pragma unroll
        for (int i = 0; i < 8; ++i) { const int idx = (t * (tp0 + i)) & 255; acc[i] += gc * tab[idx] - gs * tab[256 + idx]; } }
#pragma unroll
    for (int i = 0; i < 8; ++i) FOC[((size_t)b * CTXL + tp0 + i) * 256 + n] = acc[i] * (1.f / 128.f);
    __syncthreads();
}
__device__ __forceinline__ void phase_scan(const Ctx& X, const Args& A, int layer) {
    for (int it = X.bid; it < 96 + 64; it += X.nb) {
        if (it < 96) scan_rwkv(X, A, layer, it);
        else scan_gla(X, A, layer, it - 96);
    }
    { const bool spare = (X.nb == 256); const int dg = spare ? 96 : X.nb, dc = spare ? X.bid - 160 : X.bid;
      if (dc >= 0) { pg8::Gemm g{(const bf16*)(X.ws + O_ADFT), (const bf16*)(X.ws + O_FCT), 2 * SEQ, 2048, SEQ, SEQ, SEQ}; pg8::GroupOrder S; S.init(2, 16, 8, dg, dc, 16, 1);
          EpiDft E{(bf16*)(X.ws + O_FO)};
          __syncthreads();
          pg8::gemm_phase<EpiDft, pg8::GroupOrder>((LAS unsigned char*)X.lds, g, S, E, X.tid);
          __syncthreads(); } }
    { unsigned* qhead = (unsigned*)(X.ws + O_CTL) + 8192 + 64 * layer;
      LAS float* scr = (LAS float*)(X.lds + X.wave * 8704);
      for (;;) { unsigned r0 = 0; if (X.lane == 0) r0 = __hip_atomic_fetch_add(qhead, 16u, __ATOMIC_RELAXED, __HIP_MEMORY_SCOPE_AGENT);
          r0 = __builtin_amdgcn_readfirstlane(r0); if (r0 >= (unsigned)WEXP_ITEMS) break;
          float ta[32], tb[32]; WexpLoc La = wexp_locate(X, A, layer, (int)r0), Lb = La; wexp_issue(La, X.lane, ta);
#pragma unroll 1
          for (unsigned r = r0; r < r0 + 16u; r += 2) {
              Lb = wexp_locate(X, A, layer, (int)r + 1); wexp_issue(Lb, X.lane, tb);
              wexp_finish(La, X.lane, ta, scr);
              if (r + 2 < r0 + 16u) { La = wexp_locate(X, A, layer, (int)r + 2); wexp_issue(La, X.lane, ta); }
              wexp_finish(Lb, X.lane, tb, scr); } } }
}

struct PostRaw { u32x4 of, ob, bw, gw4; float bs0, bs1; unsigned ga[3], gb[3], og[3]; unsigned short fa[4], fb[4]; f32x4 v; };
__device__ __forceinline__ void post_load(PostRaw& R, const unsigned char* ws, const int r, const int cm, const int lane) {
    const bf16* ORW = (const bf16*)(ws + O_ORW); const bf16* OGL = (const bf16*)(ws + O_OGL); const bf16* RVp = (const bf16*)(ws + O_RV); const float* BSp = (const float*)(ws + O_BS);
    const bf16* LO = (const bf16*)(ws + O_LO); const bf16* Z = (const bf16*)(ws + O_Z); const bf16* FO = (const bf16*)(ws + O_FO); const float* FOC = (const float*)(ws + O_FOC);
    const int q = scan_row(r, cm);
    const int c1 = 8 * lane;
    if (lane < 48) { R.of = *(const u32x4*)(ORW + (size_t)q * RW + c1); R.ob = *(const u32x4*)(ORW + ((size_t)MT + q) * RW + c1); R.bw = *(const u32x4*)(RVp + (size_t)q * RW + c1); R.gw4 = *(const u32x4*)(LO + (size_t)r * LN + 1920 + c1);
        R.bs0 = BSp[(size_t)q * 6 + (lane >> 3)]; R.bs1 = BSp[((size_t)MT + q) * 6 + (lane >> 3)]; }
    const int c2 = (lane >> 4) * 96 + (lane & 15) * 6;
#pragma unroll
    for (int i = 0; i < 3; ++i) { R.ga[i] = *(const unsigned*)(OGL + (size_t)q * GVW + c2 + 2 * i); R.gb[i] = *(const unsigned*)(OGL + ((size_t)MT + q) * GVW + c2 + 2 * i); R.og[i] = *(const unsigned*)(Z + (size_t)r * NZ + ZC_OG + c2 + 2 * i); }
    if (r < ML) { const bf16* f0 = FO + (size_t)r * 256 + (lane >> 4) * 64; const bf16* f1 = f0 + (size_t)ML * 256;
#pragma unroll
        for (int e = 0; e < 4; ++e) { const int cp = (4 * lane + e) & 63, cf = cp <= 32 ? cp : 64 - cp; R.fa[e] = f0[cf]; R.fb[e] = f1[(cp == 0 || cp == 32) ? cf : 32 + cf]; } }
    else R.v = *(const f32x4*)(FOC + (size_t)(r - ML) * 256 + 4 * lane);
}
__device__ __forceinline__ void phase_post(const Ctx& X, const Args& A, int layer, int rows) {
    const int cm = layer & 1, lane = X.lane;
    const int gw = X.bid * NWAVE + X.wave, NGW = X.nb * NWAVE;
    bf16* Y = (bf16*)(X.ws + O_Y);
    const float* lnw = A.in[18] + (size_t)layer * RW; const float* lnb = A.in[19] + (size_t)layer * RW; const float* gnw = A.in[22] + (size_t)layer * 96;
    const bool p1 = lane < 48; const int c1 = 8 * lane, c2 = (lane >> 4) * 96 + (lane & 15) * 6;
    f32x4 w0 = (f32x4){0.f, 0.f, 0.f, 0.f}, w1 = w0, b0 = w0, b1 = w0; f32x2 gwt[3];
    if (p1) { w0 = *(const f32x4*)(lnw + c1); w1 = *(const f32x4*)(lnw + c1 + 4); b0 = *(const f32x4*)(lnb + c1); b1 = *(const f32x4*)(lnb + c1 + 4); }
#pragma unroll
    for (int i = 0; i < 3; ++i) gwt[i] = *(const f32x2*)(gnw + (lane & 15) * 6 + 2 * i);
    PostRaw R; R.of = R.ob = R.bw = R.gw4 = (u32x4){0u, 0u, 0u, 0u}; R.bs0 = R.bs1 = 0.f; R.v = (f32x4){0.f, 0.f, 0.f, 0.f};
#pragma unroll
    for (int e = 0; e < 4; ++e) { R.fa[e] = 0; R.fb[e] = 0; }
    if (gw < rows) post_load(R, X.ws, gw, cm, lane);
    for (int r = gw; r < rows; r += NGW) {
        const PostRaw C = R;
        if (r + NGW < rows) post_load(R, X.ws, r + NGW, cm, lane);
        if (p1) {
            const float bsc = C.bs0 + C.bs1;
            float o[8]; float sm = 0.f;
#pragma unroll
            for (int e = 0; e < 4; ++e) { o[2 * e] = bflo(C.of[e]) + bflo(C.ob[e]); o[2 * e + 1] = bfhi(C.of[e]) + bfhi(C.ob[e]); sm += o[2 * e] + o[2 * e + 1]; }
            const float mu = sum8(sm) * (1.f / 64.f); float sq = 0.f;
#pragma unroll
            for (int e = 0; e < 8; ++e) { o[e] -= mu; sq += o[e] * o[e]; }
            const float rs = __builtin_amdgcn_rsqf(sum8(sq) * (1.f / 64.f) + RW_GN_EPS);
            float y[8];
#pragma unroll
            for (int e = 0; e < 8; ++e) { const float bo = bsc * ((e & 1) ? bfhi(C.bw[e >> 1]) : bflo(C.bw[e >> 1])), gg = (e & 1) ? bfhi(C.gw4[e >> 1]) : bflo(C.gw4[e >> 1]);
                y[e] = (o[e] * rs * (e < 4 ? w0[e] : w1[e - 4]) + (e < 4 ? b0[e] : b1[e - 4]) + bo) * gg; }
            *(u32x4*)(Y + (size_t)r * D + c1) = (u32x4){pk2(y[0], y[1]), pk2(y[2], y[3]), pk2(y[4], y[5]), pk2(y[6], y[7])}; }
        { float o[6];
#pragma unroll
          for (int i = 0; i < 3; ++i) { o[2 * i] = bflo(C.ga[i]) + bflo(C.gb[i]); o[2 * i + 1] = bfhi(C.ga[i]) + bfhi(C.gb[i]); }
          float ss = 0.f;
#pragma unroll
          for (int i = 0; i < 6; ++i) ss += o[i] * o[i];
          ss = sum16(ss);
          const float rs = __builtin_amdgcn_rsqf(ss * (1.f / 96.f) + NORM_EPS);
#pragma unroll
          for (int i = 0; i < 3; ++i)
              *(unsigned*)(Y + (size_t)r * D + 384 + c2 + 2 * i) = pk2(o[2 * i] * rs * gwt[i].x * silu_f(bflo(C.og[i])), o[2 * i + 1] * rs * gwt[i].y * silu_f(bfhi(C.og[i]))); }
        { f32x4 v = C.v;
          if (r < ML) {
#pragma unroll
              for (int e = 0; e < 4; ++e) { const int cp = (4 * lane + e) & 63; const float sg = (cp == 0 || cp == 32) ? 0.f : (cp < 32 ? 1.f : -1.f);
                  v[e] = bf1(C.fa[e]) + sg * bf1(C.fb[e]); } }
          *(u32x2*)(Y + (size_t)r * D + 768 + 4 * lane) = (u32x2){pk2(v.x, v.y), pk2(v.z, v.w)}; }
    }
}

__device__ __forceinline__ void phase_norm2(const Ctx& X, const Args& A, int layer, int rows) {
    LAS float* rt = (LAS float*)X.lds;
    { const float* rw = A.in[27] + (size_t)layer * D * NE;
      for (int i = X.tid; i < D * NE; i += NTHR) { const int c = i >> 4, e = i & 15; rt[(c >> 2) * 68 + 4 * e + (c & 3)] = rw[i]; } }
    __syncthreads();
    const int gw = X.bid * NWAVE + X.wave, NGW = X.nb * NWAVE, lane = X.lane;
    const bf16* H = (const bf16*)(X.ws + O_H); bf16* U = (bf16*)(X.ws + O_U); const float* MOD = (const float*)(X.ws + O_MOD);
    float* AFFL = (float*)(X.ws + O_AFFL); float* AFFC = (float*)(X.ws + O_AFFC);
    const float* nw = A.in[7] + (size_t)layer * D;
    const int npair = rows >> 1;
    u32x2 hw[2][4];
    { const bf16* hr = H + (size_t)(gw < npair ? 2 * gw : 0) * D + 4 * lane;
#pragma unroll
      for (int q = 0; q < 2; ++q)
#pragma unroll
          for (int j = 0; j < 4; ++j) hw[q][j] = *(const u32x2*)(hr + q * D + 256 * j); }
    for (int p = gw; p < npair; p += NGW) {
        const int r0 = 2 * p, mi = mod_index(r0);
        f32x4 h[2][4]; float ss[2] = {0.f, 0.f};
#pragma unroll
        for (int q = 0; q < 2; ++q)
#pragma unroll
            for (int j = 0; j < 4; ++j) { const u32x2 w = hw[q][j]; h[q][j] = (f32x4){bflo(w.x), bfhi(w.x), bflo(w.y), bfhi(w.y)}; ss[q] += (h[q][j].x * h[q][j].x + h[q][j].y * h[q][j].y) + (h[q][j].z * h[q][j].z + h[q][j].w * h[q][j].w); }
        const float* md = MOD + ((size_t)layer * 9 + mi) * 6144 + 3072 + 4 * lane;
        f32x4 sh[4], sc[4], nwv[4];
#pragma unroll
        for (int j = 0; j < 4; ++j) { sh[j] = *(const f32x4*)(md + 256 * j); sc[j] = *(const f32x4*)(md + 1024 + 256 * j); nwv[j] = *(const f32x4*)(nw + 4 * lane + 256 * j); }
        { const int pn = p + NGW < npair ? p + NGW : p; const bf16* hn = H + (size_t)(2 * pn) * D + 4 * lane;
#pragma unroll
          for (int q = 0; q < 2; ++q)
#pragma unroll
              for (int j = 0; j < 4; ++j) hw[q][j] = *(const u32x2*)(hn + q * D + 256 * j); }
        f32x2 hp[4][4], lg2[16];
#pragma unroll
        for (int q = 0; q < 2; ++q) { const float rs = __builtin_amdgcn_rsqf(wave_sum_fast(ss[q]) * (1.f / D) + NORM_EPS);
            bf16* ur = U + (size_t)(r0 + q) * D + 4 * lane;
#pragma unroll
            for (int j = 0; j < 4; ++j) { h[q][j] = h[q][j] * rs * nwv[j] * (sc[j] + 1.f) + sh[j]; *(u32x2*)(ur + 256 * j) = (u32x2){pk2(h[q][j].x, h[q][j].y), pk2(h[q][j].z, h[q][j].w)}; } }
#pragma unroll
        for (int j = 0; j < 4; ++j)
#pragma unroll
            for (int c = 0; c < 4; ++c) hp[j][c] = (f32x2){h[0][j][c], h[1][j][c]};
#pragma unroll
        for (int e = 0; e < 16; ++e) lg2[e] = (f32x2){0.f, 0.f};
#pragma unroll
        for (int j = 0; j < 4; ++j) { asm volatile("" ::: "memory");
            const LAS float* rr = rt + (lane + 64 * j) * 68;
#pragma unroll
            for (int e = 0; e < 16; ++e) { const f32x4 wv = *(const LAS f32x4*)(rr + 4 * e);
                lg2[e] += hp[j][0] * (f32x2){wv.x, wv.x}; lg2[e] += hp[j][1] * (f32x2){wv.y, wv.y}; lg2[e] += hp[j][2] * (f32x2){wv.z, wv.z}; lg2[e] += hp[j][3] * (f32x2){wv.w, wv.w}; } }
#pragma unroll
        for (int q = 0; q < 2; ++q) { const int r = r0 + q;
            float lg[16];
#pragma unroll
            for (int e = 0; e < 16; ++e) lg[e] = q ? lg2[e].y : lg2[e].x;
            float v8[8], v4[4], v2[2], lv;
            { const bool hi = (lane & 32) != 0;
#pragma unroll
              for (int i = 0; i < 8; ++i) v8[i] = (hi ? lg[i + 8] : lg[i]) + __shfl_xor(hi ? lg[i] : lg[i + 8], 32); }
            { const bool hi = (lane & 16) != 0;
#pragma unroll
              for (int i = 0; i < 4; ++i) v4[i] = (hi ? v8[i + 4] : v8[i]) + __shfl_xor(hi ? v8[i] : v8[i + 4], 16); }
            { const bool hi = (lane & 8) != 0;
#pragma unroll
              for (int i = 0; i < 2; ++i) v2[i] = (hi ? v4[i + 2] : v4[i]) + dpp_mov<0x128>(hi ? v4[i] : v4[i + 2]); }
            { const bool hi = (lane & 4) != 0; lv = (hi ? v2[1] : v2[0]) + dpp_mov<0x141>(hi ? v2[0] : v2[1]); }
            lv = sum4(lv);
            float mx = lv;
            mx = fmaxf(mx, __shfl_xor(mx, 32)); mx = fmaxf(mx, __shfl_xor(mx, 16)); mx = fmaxf(mx, dpp_mov<0x128>(mx)); mx = fmaxf(mx, dpp_mov<0x141>(mx));
            const float ex = __expf(lv - mx);
            float den = ex; den += __shfl_xor(den, 32); den += __shfl_xor(den, 16); den += dpp_mov<0x128>(den); den += dpp_mov<0x141>(den);
            const float mine = ex * __builtin_amdgcn_rcpf(den); const int e = ((lane >> 5) & 1) * 8 + ((lane >> 4) & 1) * 4 + ((lane >> 3) & 1) * 2 + ((lane >> 2) & 1);
            if ((lane & 3) == 0) { if (r < ML) AFFL[((size_t)(r >> 12) * NE + e) * SEQ + (r & 4095)] = mine; else { const int rc = r - ML; AFFC[((size_t)(rc >> 8) * NE + e) * CTXL + (rc & 255)] = mine; } } }
    }
}

__device__ __forceinline__ int block_sum_i(const Ctx& X, LAS int* red, int v) {
#pragma unroll
    for (int o = 1; o < 64; o <<= 1) v += __shfl_xor(v, o);
    __syncthreads();
    if (X.lane == 0) red[X.wave] = v;
    __syncthreads();
    int t = 0;
#pragma unroll
    for (int w = 0; w < NWAVE; ++w) t += red[w];
    return t;
}
__device__ __forceinline__ void block_scan_flag(const Ctx& X, LAS int* red, bool f, int& excl, int& total) {
    const unsigned long long m = __ballot(f);
    const int before = __popcll(m & ((1ull << X.lane) - 1ull)), wt = __popcll(m);
    __syncthreads();
    if (X.lane == 0) red[X.wave] = wt;
    __syncthreads();
    int off = 0, t = 0;
#pragma unroll
    for (int w = 0; w < NWAVE; ++w) { const int x = red[w]; off += (w < X.wave) ? x : 0; t += x; }
    excl = off + before; total = t;
}
__device__ __forceinline__ void phase_topk(const Ctx& X, bool last) {
    LAS int* red = (LAS int*)X.lds;
    const float* AFFL = (const float*)(X.ws + O_AFFL); const float* AFFC = (const float*)(X.ws + O_AFFC);
    int* TOK = (int*)(X.ws + O_TOK); float* GATE = (float*)(X.ws + O_GATE); int* SEL = (int*)(X.ws + O_SEL);
    for (int it = X.bid; it < (last ? 128 : 256); it += X.nb) {
        const bool lat = it < 128; const int id = it & 127, b = id >> 4, e = id & 15;
        const int T = lat ? SEQ : CTXL, cap = lat ? CAPL : CAPC;
        const float* src = lat ? AFFL + ((size_t)b * NE + e) * SEQ : AFFC + ((size_t)b * NE + e) * CTXL;
        const int tokbase = lat ? b * SEQ : ML + b * CTXL, slotbase = e * ME + (lat ? b * CAPL : NB * CAPL + b * CAPC);
        unsigned x[8];
#pragma unroll
        for (int j = 0; j < 8; ++j) { const int t = X.tid + NTHR * j; x[j] = t < T ? __float_as_uint(src[t]) : 0u; }
        unsigned thr = 0u;
        for (int bit = 30; bit >= 0; --bit) { const unsigned cand = thr | (1u << bit); int cnt = 0;
#pragma unroll
            for (int j = 0; j < 8; ++j) cnt += (x[j] >= cand) ? 1 : 0;
            if (block_sum_i(X, red, cnt) >= cap) thr = cand; }
        int ngt = 0;
#pragma unroll
        for (int j = 0; j < 8; ++j) ngt += (x[j] > thr) ? 1 : 0;
        const int need = cap - block_sum_i(X, red, ngt);
        int run_sel = 0, run_eq = 0;
#pragma unroll
        for (int j = 0; j < 8; ++j) { const int t = X.tid + NTHR * j;
            if (j * NTHR < T) {
                const bool g = x[j] > thr, eq = (x[j] == thr) && (t < T);
                int ex, tot; block_scan_flag(X, red, eq, ex, tot);
                const bool sel = g || (eq && (run_eq + ex) < need);
                run_eq += tot;
                int ex2, tot2; block_scan_flag(X, red, sel, ex2, tot2);
                if (t < T) { const int slot = slotbase + run_sel + ex2;
                    if (sel) { TOK[slot] = tokbase + t; GATE[slot] = __uint_as_float(x[j]); }
                    SEL[(size_t)(tokbase + t) * NE + e] = sel ? slot : -1; }
                run_sel += tot2;
            } }
        __syncthreads();
    }
}

__device__ __forceinline__ void phase_gather(const Ctx& X, bool last) {
    const int gw = X.bid * NWAVE + X.wave, NGW = X.nb * NWAVE;
    const int* TOK = (const int*)(X.ws + O_TOK); const bf16* U = (const bf16*)(X.ws + O_U); bf16* XS = (bf16*)(X.ws + O_XS);
    for (int s = gw; s < MXR; s += 4 * NGW) {
        int r[4]; bool ok[4]; u32x4 a[4][2];
#pragma unroll
        for (int k = 0; k < 4; ++k) { const int sk = s + k * NGW; ok[k] = sk < MXR && !(last && (sk % ME) >= NB * CAPL); r[k] = ok[k] ? TOK[sk] : 0; }
#pragma unroll
        for (int k = 0; k < 4; ++k) { const u32x4* src = (const u32x4*)(U + (size_t)r[k] * D) + X.lane; a[k][0] = src[0]; a[k][1] = src[64]; }
#pragma unroll
        for (int k = 0; k < 4; ++k) if (ok[k]) { u32x4* dst = (u32x4*)(XS + (size_t)(s + k * NGW) * D) + X.lane; dst[0] = a[k][0]; dst[64] = a[k][1]; } }
}

constexpr int NPH = 14;
constexpr int GP_END = 1 + DEPTH * NPH + 1;

__global__ void __launch_bounds__(NTHR, 2) fwd_kernel(Args args) {
    extern __shared__ __attribute__((aligned(16))) unsigned char lds_raw[];
    Ctx X;
    X.out = args.out; X.ws = args.ws; X.lds = (LAS unsigned char*)lds_raw;
    X.tid = threadIdx.x; X.lane = X.tid & 63; X.wave = __builtin_amdgcn_readfirstlane(X.tid >> 6); X.bid = blockIdx.x; X.nb = gridDim.x;
    const int wave0 = X.wave;
    volatile LAS unsigned* misc = (volatile LAS unsigned*)(X.lds + LDS_MISC);
    if (X.tid < 64) misc[X.tid] = 0u;
    __syncthreads();
    const int lo = args.lo, hi = args.hi;
    if (hi - lo > 1) (void)xcd_barrier_post((unsigned*)(X.ws + O_CTL) + 4096, misc + 8);
    LAS unsigned char* glds = (LAS unsigned char*)X.lds;
#define RUN(gp) ((gp) >= lo && (gp) < hi)
#define FRESH() do { int wv_ = wave0; asm volatile("" : "+s"(wv_)); int t_ = wv_ * 64 + (int)__builtin_amdgcn_mbcnt_hi(~0u, __builtin_amdgcn_mbcnt_lo(~0u, 0u)); asm volatile("" : "+v"(t_)); X.tid = t_; X.lane = t_ & 63; X.wave = wv_; int nb_ = gridDim.x, bid_ = blockIdx.x; asm volatile("" : "+s"(nb_), "+s"(bid_)); X.nb = nb_; X.bid = bid_; unsigned long long w_ = (unsigned long long)args.ws; asm volatile("" : "+s"(w_)); X.ws = (unsigned char*)(__attribute__((address_space(1))) unsigned char*)w_;     lyr = layer; asm volatile("" : "+s"(lyr)); } while (0)
#define SEAM(gp) do { if ((gp) + 1 < hi) { XcdBarrier bb_; bb_.bar = (unsigned*)(X.ws + O_CTL) + 4096; bb_.x = xb_xcc_id(); bb_.st = (volatile LAS unsigned*)(X.lds + LDS_MISC) + 8; xcd_barrier(bb_); } } while (0)

    int lyr = 0; const int layer = 0;
    if (RUN(0)) { FRESH(); phase_prologue(X, args); SEAM(0); }
    for (int layer = 0; layer < DEPTH; ++layer) {
        const int g0 = 1 + layer * NPH;
        const bool last = (layer == DEPTH - 1); const int rows = last ? ML : MT;
        if (RUN(g0 + 0)) { FRESH(); phase_weights(X, args, lyr); phase_norm1<false>(X, args, lyr); SEAM(g0 + 0); }
        if (RUN(g0 + 1)) { FRESH();
            pg8::Gemm g{(const bf16*)(X.ws + O_U), (const bf16*)(X.ws + O_WIN), MT, NZ, D, D, D}; pg8::StaticOrder S; S.init(MT, NZ, X.nb, X.bid);
            EpiZ E{(bf16*)(X.ws + O_Z), (bf16*)(X.ws + O_FCT)};
            pg8::gemm_phase<EpiZ, pg8::StaticOrder>(glds, g, S, E, X.tid); SEAM(g0 + 1); }
        if (RUN(g0 + 2)) { FRESH(); for (int it = X.bid; it < 128; it += X.nb) ctx_dft(X, it); phase_conv(X, args, lyr); FRESH();
            { pg8::Gemm g{(const bf16*)(X.ws + O_Z) + ZC_LIN, (const bf16*)(X.ws + O_LORA), MT, LN, LK, NZ, LK}; pg8::LoraOrder S;     S.init(MT, LN, X.nb, X.bid);
              EpiBf16Store E{(bf16*)(X.ws + O_LO), LN};
              pg8::gemm_phase<EpiBf16Store, pg8::LoraOrder>(glds, g, S, E, X.tid); }
            SEAM(g0 + 2); }
        if (RUN(g0 + 5)) { FRESH(); phase_scan(X, args, lyr); SEAM(g0 + 5); }
        if (RUN(g0 + 6)) { FRESH(); phase_post(X, args, lyr, rows); SEAM(g0 + 6); }
        if (RUN(g0 + 7)) { FRESH();
            pg8::Gemm g{(const bf16*)(X.ws + O_Y), (const bf16*)(X.ws + O_PT), MT, D, D, D, D}; pg8::Merge3Order S; S.init(rows, D, X.nb, X.bid);
            EpiMerge3 E{(bf16*)(X.ws + O_MX), (const bf16*)(X.ws + O_Z)};
            pg8::gemm_phase<EpiMerge3, pg8::Merge3Order>(glds, g, S, E, X.tid); SEAM(g0 + 7); }
        if (RUN(g0 + 8)) { FRESH();
            pg8::Gemm g{(const bf16*)(X.ws + O_MX), (const bf16*)(X.ws + O_WOT), MT, D, D, D, D}; pg8::StaticOrder S; S.init(rows, D, X.nb, X.bid);
            EpiResid E{(bf16*)(X.ws + O_H), (const float*)(X.ws + O_MOD) + (size_t)lyr * 9 * 6144};
            pg8::gemm_phase<EpiResid, pg8::StaticOrder>(glds, g, S, E, X.tid); SEAM(g0 + 8); }
        if (RUN(g0 + 9)) { FRESH(); phase_norm2(X, args, lyr, rows); SEAM(g0 + 9); }
        if (RUN(g0 + 10)) { FRESH(); phase_topk(X, last); SEAM(g0 + 10); }
        if (RUN(g0 + 11)) { FRESH(); phase_gather(X, last); SEAM(g0 + 11); }
        if (RUN(g0 + 12)) { FRESH();
            pg8::Gemm g{(const bf16*)(X.ws + O_XS), (const bf16*)(X.ws + O_W13), MXR, NE * 4096, D, D, D}; pg8::GroupOrder S; S.init(NE, last ? NB * CAPL / 256 : ME / 256, 16, X.nb, X.bid, ME / 256);
            EpiHid E{(bf16*)(X.ws + O_HID)};
            pg8::gemm_phase<EpiHid, pg8::GroupOrder>(glds, g, S, E, X.tid); SEAM(g0 + 12); }
        if (RUN(g0 + 13)) { FRESH();
            pg8::Gemm g{(const bf16*)(X.ws + O_HID), (const bf16*)(X.ws + O_W2T), MXR, NE * D, EH, EH, EH}; pg8::W2Order S; S.init(NE, last ? NB * CAPL / 256 : ME / 256, X.nb, X.bid, ME / 256);
            EpiExpertOut E{(bf16*)(X.ws + O_XS), (const float*)(X.ws + O_GATE), (bf16*)(X.ws + O_YP)};
            pg8::gemm_phase<EpiExpertOut, pg8::W2Order>(glds, g, S, E, X.tid); SEAM(g0 + 13); }
    }
    if (RUN(GP_END - 1)) { const int layer = DEPTH; FRESH(); phase_norm1<true>(X, args, lyr); }
#undef RUN
#undef SEAM
}

extern "C" void kernel_launch(void* const* d_in, const int* in_sizes, int n_in, void* d_out, int out_size, void* d_ws, size_t ws_size, hipStream_t stream) {
    static int grid = 0;
    if (grid == 0) {
        if (n_in != 32 || in_sizes[0] != ML * D || out_size != ML * D || ws_size < WS_END) {
            fprintf(stderr, "kernel_launch: unexpected shapes (n_in %d, in0 %d, out %d, ws %zu, need %zu); nothing launched\n", n_in, n_in > 0 ? in_sizes[0] : -1, out_size, ws_size, (size_t)WS_END); grid = -1; return; }
        int dev = 0, cus = 0, per_cu = 0;
        if (hipGetDevice(&dev) != hipSuccess || hipDeviceGetAttribute(&cus, hipDeviceAttributeMultiprocessorCount, dev) != hipSuccess) { grid = -1; return; }
        if (hipFuncSetAttribute((const void*)fwd_kernel, hipFuncAttributeMaxDynamicSharedMemorySize, LDS_BYTES) != hipSuccess) { fprintf(stderr, "kernel_launch: hipFuncSetAttribute failed\n"); grid = -1; return; }
        if (hipOccupancyMaxActiveBlocksPerMultiprocessor(&per_cu, (const void*)fwd_kernel, NTHR, LDS_BYTES) != hipSuccess || per_cu < 1) { fprintf(stderr, "kernel_launch: occupancy query says %d\n", per_cu); }
        (void)hipGetLastError();
        grid = cus;
    }
    if (grid < 0) return;
    (void)hipMemsetAsync((char*)d_ws + O_CTL, 0, SZ_CTL, stream);
    Args a{};
    for (int i = 0; i < 32; ++i) a.in[i] = (const float*)d_in[i];
    a.out = (float*)d_out; a.ws = (unsigned char*)d_ws;
#if N_LAUNCH_MODE == 1
    a.lo = 0; a.hi = GP_END;
    hipLaunchKernelGGL(fwd_kernel, dim3(grid), dim3(NTHR), LDS_BYTES, stream, a);
#else
    for (int gp = 0; gp < GP_END; ++gp) { a.lo = gp; a.hi = gp + 1; hipLaunchKernelGGL(fwd_kernel, dim3(grid), dim3(NTHR), LDS_BYTES, stream, a); }
#endif
}
```

```cpp
#include <hip/hip_runtime.h>
#include <cstdio>
#include <cstdint>

#ifndef N_LAUNCH_MODE
#define N_LAUNCH_MODE 1
#endif

namespace pg8 {
#define PG8_LAS __attribute__((address_space(3)))
typedef unsigned short bf16_t;
typedef short bf16x8 __attribute__((ext_vector_type(8)));
typedef float f32x4 __attribute__((ext_vector_type(4)));
typedef unsigned u32x4 __attribute__((ext_vector_type(4)));
constexpr int BM = 256, BK = 64, HALF = 128, HTB = HALF * BK * 2  , STAGE_BYTES = 8 * HTB, NXCD = 8, WGM = 8;

__host__ __device__ __forceinline__ int lds_byte(int r, int c) { const int st = (r >> 4) * 2 + (c >> 5), rr = r & 15, cc = c & 31, ob = rr * 64 + cc * 2; return st * 1024 + (ob ^ (((ob >> 9) & 1) << 5)); }
__host__ __device__ __forceinline__ void stage_rc(int b, int& R, int& C) { const int st = b / 1024, sb = b % 1024, swz = sb ^ (((sb >> 9) & 1) << 5); R = (st >> 1) * 16 + swz / 64; C = (st & 1) * 32 + (swz % 64) / 2; }
__host__ __device__ __forceinline__ int perm32(int rho) { const int n = rho >> 4, i = rho & 15; return 8 * (i >> 2) + 4 * n + (i & 3); }

struct Unit { int pm, pn, koff, nt, aux; };
struct Gemm { const bf16_t* A; const bf16_t* Bt; int M, N, K, lda, ldb; };

struct StaticOrder {
    int nM, nN, nwg, G, c;
    __host__ __device__ void init(int M, int N, int G_, int c_) { nM = M / BM; nN = N / BM; nwg = nM * nN; G = G_; c = c_; }
    __host__ __device__ bool next(int i, Unit& u) const {
        const long L = (long)i * G + c; if (L >= nwg) return false;
        int wgid = (int)L; { const int q = nwg / NXCD, r = nwg % NXCD, xcd = wgid % NXCD, off = wgid / NXCD; wgid = (xcd < r ? xcd * (q + 1) : r * (q + 1) + (xcd - r) * q) + off; }
        const int nig = WGM * nN, gid = wgid / nig, fm = gid * WGM, gsz = (nM - fm) < WGM ? (nM - fm) : WGM;
        u.pm = fm + ((wgid % nig) % gsz); u.pn = (wgid % nig) / gsz; u.koff = 0; u.nt = 0; u.aux = 0; return true;
    }
    __device__ __forceinline__ void a_ready(const Unit&) const {}
    __device__ __forceinline__ void done(const Unit&) const {}
};
struct GroupOrder {
    int ngroups, nm, nn, G, c, gm, shb;
    __host__ __device__ void init(int ng_, int nm_, int nn_, int G_, int c_, int gm_, int shb_ = 0) { ngroups = ng_; nm = nm_; nn = nn_; G = G_; c = c_; gm = gm_; shb = shb_; }
    __host__ __device__ bool next(int i, Unit& u) const {
        u.koff = 0; u.nt = 0; u.aux = 0;
        const int per = nm * nn;
        if (G == 256 && (ngroups & 7) == 0) {
            const int x = c & 7, slot = c >> 3, gpx = ngroups >> 3; const long s = (long)i * 32 + slot; if (s >= (long)gpx * per) return false;
            const int grp = x * gpx + (int)(s / per), rem = (int)(s % per);
            const int nig = WGM * nn, gid = rem / nig, fm = gid * WGM, gsz = (nm - fm) < WGM ? (nm - fm) : WGM;
            u.pm = grp * gm + fm + ((rem % nig) % gsz); u.pn = grp * nn + (rem % nig) / gsz; return true; }
        const long L = (long)i * G + c; if (L >= (long)ngroups * per) return false;
        const int grp = (int)(L / per), rem = (int)(L % per);
        u.pm = grp * gm + rem % nm; u.pn = (shb ? 0 : grp * nn) + rem / nm; u.aux = grp; return true;
    }
    __device__ __forceinline__ void a_ready(const Unit&) const {}
    __device__ __forceinline__ void done(const Unit&) const {}
};
struct LoraOrder {
    StaticOrder base;
    __host__ __device__ void init(int M, int N, int G_, int c_) { base.init(M, N, G_, c_); }
    __host__ __device__ bool next(int i, Unit& u) const { if (!base.next(i, u)) return false; const int p = u.pn; u.koff = p < 3 ? 0 : p < 6 ? 128 : 256; u.nt = p < 7 ? 2 : 4; return true; }
    __device__ __forceinline__ void a_ready(const Unit&) const {}
    __device__ __forceinline__ void done(const Unit&) const {}
};
struct Merge3Order {
    StaticOrder base;
    __host__ __device__ void init(int M, int N, int G_, int c_) { base.init(M, N, G_, c_); }
    __host__ __device__ bool next(int i, Unit& u) const { if (!base.next(i / 3, u)) return false; const int br = i % 3; u.aux = br; u.koff = 384 * br; u.nt = br < 2 ? 6 : 4; return true; }
    __device__ __forceinline__ void a_ready(const Unit&) const {}
    __device__ __forceinline__ void done(const Unit&) const {}
};
typedef float f32x2 __attribute__((ext_vector_type(2)));
typedef __bf16 bf16x2_hw __attribute__((ext_vector_type(2)));
__device__ __forceinline__ unsigned cvt_pk_bf16(float lo, float hi) { const f32x2 v = (f32x2){lo, hi}; return __builtin_bit_cast(unsigned, __builtin_convertvector(v, bf16x2_hw)); }

template <class Epi, class Sched, bool GATHER = false>
__device__ __forceinline__ void gemm_phase(PG8_LAS unsigned char* lds, const Gemm g, const Sched& S, const Epi& E, int tid_in, const int* tok = nullptr) {
    int tid_ = tid_in; asm volatile("" : "+v"(tid_));
    const int tid = tid_, wid = __builtin_amdgcn_readfirstlane(tid >> 6), lane = tid & 63, wr = wid >> 2, wc = wid & 3, fr = lane & 15, fq = lane >> 4;
    const int K = g.K, nt = K / BK;
    unsigned voffA[2], voffB[2];
#pragma unroll
    for (int i = 0; i < 2; ++i) { int R, C; stage_rc(tid * 16 + i * 8192, R, C); const int Rb = Epi::PERM ? ((R & ~31) + perm32(R & 31)) : R;
        voffA[i] = (unsigned)(R * g.lda + C) * 2u; voffB[i] = (unsigned)(Rb * g.ldb + C) * 2u; }
    const size_t kstep = (size_t)(BK * 2);
    const size_t hstepA = (size_t)HALF * g.lda * 2, hstepB = (size_t)HALF * g.ldb * 2;
    const size_t tstepA = 2 * hstepA, tstepB = 2 * hstepB;
    const unsigned ldsw = (unsigned)wid * 1024u;
    const int aoff = lds_byte(wr * 64 + fr, fq * 8), boff = lds_byte(wc * 32 + fr, fq * 8);
#define PG8_SA(b, h) (((b) * 2 + (h)) * HTB)
#define PG8_SB(b, h) ((4 + (b) * 2 + (h)) * HTB)
    unsigned gcu[2][2] = {{0u, 0u}, {0u, 0u}};
    PG8_LAS int* gtab = (PG8_LAS int*)(lds + STAGE_BYTES);
#define PG8_STAGE(bufoff, gbase, voff) do { _Pragma("unroll") for (int _i = 0; _i < 2; ++_i) \
        __builtin_amdgcn_global_load_lds((const unsigned*)((const char*)(gbase) + (voff)[_i]), (PG8_LAS unsigned*)(lds + (bufoff) + ldsw + _i * 8192), 16, 0, 0); } while (0)
#define PG8_STAGE_A(bufoff, kptr, h) do { if constexpr (GATHER) PG8_STAGE(bufoff, kptr, gcu[h]); else PG8_STAGE(bufoff, (kptr) + (h) * hstepA, voffA); } while (0)
#define PG8_GOFF(ui_) do { _Pragma("unroll") for (int h_ = 0; h_ < 2; ++h_) _Pragma("unroll") for (int i_ = 0; i_ < 2; ++i_) { int R_, C_; stage_rc(tid * 16 + i_ * 8192, R_, C_); \
        gcu[h_][i_] = (unsigned)gtab[(ui_) * 256 + h_ * 128 + R_] * (unsigned)(g.lda * 2) + (unsigned)(C_ * 2); } } while (0)
#define PG8_LDA(dst, b, h) do { _Pragma("unroll") for (int m = 0; m < 4; ++m) _Pragma("unroll") for (int k = 0; k < 2; ++k) dst[m][k] = *(const PG8_LAS bf16x8*)(lds + PG8_SA(b, h) + aoff + m * 2048 + k * 1024); } while (0)
#define PG8_LDB(dst, b, h) do { _Pragma("unroll") for (int n = 0; n < 2; ++n) _Pragma("unroll") for (int k = 0; k < 2; ++k) dst[n][k] = *(const PG8_LAS bf16x8*)(lds + PG8_SB(b, h) + boff + n * 2048 + k * 1024); } while (0)
#define PG8_MMA(ai, bj, At, Bt) do { __builtin_amdgcn_s_setprio(1); _Pragma("unroll") for (int m = 0; m < 4; ++m) _Pragma("unroll") for (int n = 0; n < 2; ++n) _Pragma("unroll") for (int k = 0; k < 2; ++k) \
        acc[ai][bj][m][n] = __builtin_amdgcn_mfma_f32_16x16x32_bf16(Bt[n][k], At[m][k], acc[ai][bj][m][n], 0, 0, 0); __builtin_amdgcn_s_setprio(0); } while (0)
#define PG8_WAIT_V(n) asm volatile("s_waitcnt vmcnt(" #n ")" ::: "memory")
#define PG8_WAIT_L(n) asm volatile("s_waitcnt lgkmcnt(" #n ")" ::: "memory")
#define PG8_BAR __builtin_amdgcn_s_barrier()
#define PG8_SCHED __builtin_amdgcn_sched_barrier(0)
    Unit cur, nxt; int ui = 0;
    if (!S.next(0, cur)) return;
    f32x4 acc[2][2][4][2];
#pragma unroll
    for (int a = 0; a < 2; ++a)
#pragma unroll
        for (int b = 0; b < 2; ++b)
#pragma unroll
            for (int m = 0; m < 4; ++m)
#pragma unroll
                for (int n = 0; n < 2; ++n) acc[a][b][m][n] = (f32x4){0.f, 0.f, 0.f, 0.f};
    bf16x8 At[4][2], B0[2][2], B1[2][2];
    const char* cA = (const char*)g.A + (GATHER ? (size_t)0 : (size_t)cur.pm * tstepA) + 2 * cur.koff; const char* cB = (const char*)g.Bt + (size_t)cur.pn * tstepB + 2 * cur.koff;
    if constexpr (GATHER) {
        int nun = 0; { Unit uu; while (nun < 31 && S.next(nun, uu)) ++nun; }
        int tv[16];
#pragma unroll
        for (int k = 0; k < 16; ++k) { const int e = tid + 512 * k, ui = e >> 8; Unit uu; tv[k] = 0; if (ui < nun) { (void)S.next(ui, uu); tv[k] = tok[uu.pm * 256 + (e & 255)]; } }
#pragma unroll
        for (int k = 0; k < 16; ++k) { const int e = tid + 512 * k; if ((e >> 8) < nun) gtab[e] = tv[k]; }
        asm volatile("s_waitcnt vmcnt(0) lgkmcnt(0)" ::: "memory"); PG8_BAR;
        PG8_GOFF(0); }
    S.a_ready(cur);
    PG8_STAGE(PG8_SB(0, 0), cB, voffB); PG8_STAGE_A(PG8_SA(0, 0), cA, 0); PG8_STAGE(PG8_SB(0, 1), cB + hstepB, voffB); PG8_STAGE_A(PG8_SA(0, 1), cA, 1);
    if (wr == 1) PG8_BAR;
    PG8_WAIT_V(4); PG8_BAR;
    PG8_STAGE(PG8_SB(1, 0), cB + kstep, voffB); PG8_STAGE_A(PG8_SA(1, 0), cA + kstep, 0); PG8_STAGE(PG8_SB(1, 1), cB + hstepB + kstep, voffB);
    PG8_WAIT_V(6); PG8_BAR;
    for (;;) {
        const bool has_next = S.next(ui + 1, nxt);
        const char* nA = has_next ? (const char*)g.A + (GATHER ? (size_t)0 : (size_t)nxt.pm * tstepA) + 2 * nxt.koff : cA; const char* nB = has_next ? (const char*)g.Bt + (size_t)nxt.pn * tstepB + 2 * nxt.koff : cB;
        const int cnt = cur.nt ? cur.nt : nt;
        for (int t = 0; t < cnt; t += 2) {
            const bool last = (t == cnt - 2);
            if constexpr (Epi::HAS_MID) { if (t == Epi::MID0 || t == Epi::MID1) E.mid(acc, cur, t, wr, wc, fr, fq); }
            const char* a1 = cA + (size_t)(t + 1) * kstep;
            const char* a2 = last ? nA : cA + (size_t)(t + 2) * kstep; const char* b2 = last ? nB : cB + (size_t)(t + 2) * kstep;
            const char* a3 = a2 + kstep; const char* b3 = b2 + kstep;
            if (last && has_next) S.a_ready(nxt);
            PG8_LDB(B0, 0, 0); PG8_SCHED; PG8_LDA(At, 0, 0); PG8_STAGE_A(PG8_SA(1, 1), a1, 1);
            if constexpr (GATHER) { if (last && has_next) PG8_GOFF(ui + 1); }
            PG8_WAIT_L(8); PG8_BAR; PG8_WAIT_L(0); PG8_MMA(0, 0, At, B0); PG8_BAR; PG8_SCHED;
            PG8_LDB(B1, 0, 1); PG8_STAGE(PG8_SB(0, 0), b2, voffB);
            PG8_BAR; PG8_WAIT_L(0); PG8_MMA(0, 1, At, B1); PG8_BAR;
            PG8_LDA(At, 0, 1); PG8_STAGE_A(PG8_SA(0, 0), a2, 0);
            PG8_BAR; PG8_WAIT_L(0); PG8_MMA(1, 0, At, B0); PG8_BAR; PG8_SCHED;
            PG8_STAGE(PG8_SB(0, 1), b2 + hstepB, voffB);
            PG8_WAIT_V(6); PG8_BAR; PG8_MMA(1, 1, At, B1); PG8_BAR;
            PG8_LDB(B0, 1, 0); PG8_SCHED; PG8_LDA(At, 1, 0); PG8_STAGE_A(PG8_SA(0, 1), a2, 1);
            PG8_WAIT_L(8); PG8_BAR; PG8_WAIT_L(0); PG8_MMA(0, 0, At, B0); PG8_BAR; PG8_SCHED;
            PG8_LDB(B1, 1, 1); PG8_STAGE(PG8_SB(1, 0), b3, voffB);
            PG8_BAR; PG8_WAIT_L(0); PG8_MMA(0, 1, At, B1); PG8_BAR;
            PG8_LDA(At, 1, 1); PG8_STAGE_A(PG8_SA(1, 0), a3, 0);
            PG8_BAR; PG8_WAIT_L(0); PG8_MMA(1, 0, At, B0); PG8_BAR; PG8_SCHED;
            PG8_STAGE(PG8_SB(1, 1), b3 + hstepB, voffB);
            PG8_WAIT_V(6); PG8_BAR; PG8_MMA(1, 1, At, B1); PG8_BAR;
        }
        if constexpr (!Epi::AFTER_DRAIN) { E(acc, cur, wr, wc, fr, fq); S.done(cur); }
        if (!has_next) break;
#pragma unroll
        for (int a = 0; a < 2; ++a)
#pragma unroll
            for (int b = 0; b < 2; ++b)
#pragma unroll
                for (int m = 0; m < 4; ++m)
#pragma unroll
                    for (int n = 0; n < 2; ++n) acc[a][b][m][n] = (f32x4){0.f, 0.f, 0.f, 0.f};
        cur = nxt; cA = nA; cB = nB; ++ui;
    }
    PG8_WAIT_V(0);
    if (wr == 0) PG8_BAR;
    PG8_BAR;
    if constexpr (Epi::AFTER_DRAIN) { E.fused(acc, cur, wr, wc, fr, fq, lds, wid, lane); S.done(cur); }
#undef PG8_SA
#undef PG8_SB
#undef PG8_STAGE
#undef PG8_STAGE_A
#undef PG8_GOFF
#undef PG8_LDA
#undef PG8_LDB
#undef PG8_MMA
#undef PG8_WAIT_V
#undef PG8_WAIT_L
#undef PG8_BAR
#undef PG8_SCHED
}
}

#define XB_TMO      128
#define XB_XCNT(j)  (256  + 64 * (j))
#define XB_XSUB(j)  (1280 + 64 * (j))
#define XB_XGEN(j)  (2304 + 64 * (j))
#define XB_TOP      3328
#define XB_TOPGEN   3392
#define XCD_BAR_WORDS 3456
#define XB_SPIN_CAP (1u << 22)
#define LAS __attribute__((address_space(3)))

__device__ __forceinline__ unsigned xb_ld(unsigned* p)              { return __hip_atomic_load(p, __ATOMIC_RELAXED, __HIP_MEMORY_SCOPE_AGENT); }
__device__ __forceinline__ unsigned xb_add(unsigned* p, unsigned v) { return __hip_atomic_fetch_add(p, v, __ATOMIC_RELAXED, __HIP_MEMORY_SCOPE_AGENT); }
__device__ __forceinline__ unsigned xb_xcc_id() { return (unsigned)__builtin_amdgcn_s_getreg((3 << 11) | 20) & 0xFu; }
#define XB_SPIN(cond, bar) do { unsigned _sp = 0; while (cond) { __builtin_amdgcn_s_sleep(1); \
    if ((++_sp & 255u) == 0u) { if (xb_ld(&(bar)[XB_TMO])) break; if (_sp > XB_SPIN_CAP) { atomicAdd(&(bar)[XB_TMO], 1u); break; } } } } while (0)

struct XcdBarrier {
    unsigned* bar; unsigned x;
    volatile LAS unsigned* st;
};

__device__ __forceinline__ XcdBarrier xcd_barrier_post(unsigned* bar, volatile LAS unsigned* st) {
    XcdBarrier b; b.bar = bar; b.x = xb_xcc_id(); b.st = st;
    if (threadIdx.x == 0) (void)xb_add(&bar[XB_XCNT(b.x)], 1u);
    return b;
}
__device__ __forceinline__ void xcd_barrier_complete(unsigned* bar, unsigned x, unsigned& nloc, unsigned& nx) {
    const unsigned G = gridDim.x * gridDim.y * gridDim.z;
    unsigned sum, cnt, mine, sp = 0u;
    for (;;) {
        sum = 0u; cnt = 0u; mine = 0u;
#pragma unroll
        for (unsigned j = 0; j < 16; ++j) { const unsigned c = xb_ld(&bar[XB_XCNT(j)]); sum += c; cnt += (c > 0u) ? 1u : 0u; mine = (j == x) ? c : mine; }
        if (sum == G) break;
        __builtin_amdgcn_s_sleep(1);
        if ((++sp & 255u) == 0u) { if (xb_ld(&bar[XB_TMO])) break; if (sp > XB_SPIN_CAP) { atomicAdd(&bar[XB_TMO], 1u); break; } }
    }
    nloc = mine > 0u ? mine : 1u; nx = cnt > 0u ? cnt : 1u;
}

__device__ __forceinline__ void xcd_barrier(const XcdBarrier& b) {
    asm volatile("s_waitcnt vmcnt(0)" ::: "memory");
    __syncthreads();
    if (threadIdx.x == 0) {
        unsigned* bar = b.bar;
        __builtin_amdgcn_s_waitcnt(0);
        unsigned nloc = b.st[0], nx = b.st[1];
        if (nloc == 0u) { xcd_barrier_complete(bar, b.x, nloc, nx); b.st[0] = nloc; b.st[1] = nx; }
        const unsigned old = xb_add(&bar[XB_XSUB(b.x)], 1u);
        const unsigned gen = old / nloc;
        if (old + 1u == (gen + 1u) * nloc) {
            __builtin_amdgcn_fence(__ATOMIC_RELEASE, "agent");
            asm volatile("s_waitcnt vmcnt(0)" ::: "memory");
            const unsigned og = xb_add(&bar[XB_TOP], 1u);
            const unsigned tg = og / nx;
            if (og + 1u == (tg + 1u) * nx) xb_add(&bar[XB_TOPGEN], 1u);
            else XB_SPIN(xb_ld(&bar[XB_TOPGEN]) == tg, bar);
            __builtin_amdgcn_fence(__ATOMIC_ACQUIRE, "agent");
            xb_add(&bar[XB_XGEN(b.x)], 1u);
            asm volatile("s_waitcnt vmcnt(0)" ::: "memory");
        } else {
            XB_SPIN(xb_ld(&bar[XB_XGEN(b.x)]) == gen, bar);
            __builtin_amdgcn_fence(__ATOMIC_ACQUIRE, "agent");
            asm volatile("s_waitcnt vmcnt(0)" ::: "memory");
        }
    }
    __syncthreads();
}

typedef unsigned short bf16;
typedef float f32x4 __attribute__((ext_vector_type(4)));
typedef float f32x2 __attribute__((ext_vector_type(2)));
typedef unsigned u32x4 __attribute__((ext_vector_type(4)));
typedef unsigned u32x2 __attribute__((ext_vector_type(2)));

constexpr int D = 1024, NB = 8, SEQ = 4096, CTXL = 256, DEPTH = 4;
constexpr int ML = NB * SEQ, MC = NB * CTXL, MT = ML + MC;
constexpr int NZ = 6144, INCOLS = 6048;
constexpr int RW = 384, GKW = 192, GVW = 384, FNW = 256, CONVC = 1920;
constexpr int ZC_R = 0, ZC_K = 384, ZC_V = 768, ZC_GQ = 1152, ZC_GK = 1344, ZC_GV = 1536, ZC_LIN = 1920, ZC_OG = 2336, ZC_FP = 2720, ZC_GATE = 2976, ZC_END = 6048;
constexpr int SRC_FN = 2720, SRC_GATE = 2976;
constexpr int NE = 16, EH = 2048, CAPL = 512, CAPC = 32, ME = NB * CAPL + NB * CAPC  , MXR = NE * ME  ;
constexpr int LK = 512, LN = 2304;
constexpr int NTHR = 512, NWAVE = 8;
constexpr float NORM_EPS = 1e-6f, RW_GN_EPS = 64e-5f;

constexpr size_t KiB = 1024, MiB = 1024 * 1024;
constexpr size_t al256(size_t x) { return (x + 255) & ~(size_t)255; }
constexpr size_t O_CTL  = 0,                         SZ_CTL  = 1 * MiB;
constexpr size_t O_MOD  = O_CTL + SZ_CTL,            SZ_MOD  = al256((size_t)DEPTH * 9 * 6144 * 4);
constexpr size_t O_AFFL = O_MOD + SZ_MOD,            SZ_AFFL = (size_t)NB * NE * SEQ * 4;
constexpr size_t O_AFFC = O_AFFL + SZ_AFFL,          SZ_AFFC = (size_t)NB * NE * CTXL * 4;
constexpr size_t O_TOK  = O_AFFC + SZ_AFFC,          SZ_TOK  = al256((size_t)MXR * 4);
constexpr size_t O_GATE = O_TOK + SZ_TOK,            SZ_GATE = al256((size_t)MXR * 4);
constexpr size_t O_SEL  = O_GATE + SZ_GATE,          SZ_SEL  = (size_t)MT * NE * 4;
constexpr size_t O_FOC  = O_SEL + SZ_SEL,              SZ_FOC  = (size_t)MC * 256 * 4;
constexpr size_t O_H    = O_FOC + SZ_FOC,            SZ_H    = (size_t)MT * D * 4;
constexpr size_t O_U    = O_H + SZ_H,                SZ_U    = (size_t)MT * D * 2;
constexpr size_t O_Z    = O_U + SZ_U,                SZ_Z    = (size_t)MT * NZ * 2;
constexpr size_t O_XS   = O_Z,                       SZ_XS   = (size_t)MXR * D * 2;
constexpr size_t O_HID  = O_XS + SZ_XS,              SZ_HID  = (size_t)MXR * EH * 2;
static_assert(SZ_XS + SZ_HID <= SZ_Z, "XS|HID overlay Z");
constexpr size_t O_KT   = O_Z + SZ_Z,                SZ_KT   = (size_t)MT * RW * 2;
constexpr size_t O_LO   = O_KT + SZ_KT,            SZ_LO   = (size_t)MT * LN * 2;
constexpr size_t O_RR   = O_LO + SZ_LO,              SZ_R384 = (size_t)MT * RW * 2;
constexpr size_t O_RV   = O_RR + SZ_R384;
constexpr size_t O_RKK  = O_RV + SZ_R384;
constexpr size_t O_RKM  = O_RKK + SZ_R384;
constexpr size_t O_RBB  = O_RKM + 2 * SZ_R384;
constexpr size_t O_ADFTC = O_RBB;
constexpr size_t O_FCTC = O_RBB + 1 * MiB;
constexpr size_t O_RLD  = O_RBB + 2 * SZ_R384,       SZ_F384 = (size_t)MT * RW * 4;
constexpr size_t O_G8   = O_RLD;
static_assert((size_t)MT * 3072 <= 2 * SZ_F384, "the gate bytes must fit the old log-decay region");
constexpr size_t O_GQ   = O_RLD + 2 * SZ_F384,       SZ_G192 = (size_t)MT * GKW * 2;
constexpr size_t O_GK   = O_GQ + SZ_G192;
constexpr size_t O_GV   = O_GK + SZ_G192;
constexpr size_t O_GLA  = O_GV + SZ_R384,            SZ_F192 = (size_t)MT * GKW * 4;
constexpr size_t O_ORW  = O_GLA + 2 * SZ_F192;
constexpr size_t O_OGL  = O_ORW + 2 * SZ_F384;
constexpr size_t O_BON  = O_OGL + 2 * SZ_F384;
constexpr size_t O_BS   = O_BON;
constexpr size_t O_Y    = O_BON + SZ_F384,           SZ_Y    = (size_t)MT * D * 2;
constexpr size_t O_MX   = O_Y + SZ_Y;
constexpr size_t O_ADFT = O_MX + SZ_Y,               SZ_ADFT = (size_t)2 * SEQ * SEQ * 2;
constexpr size_t O_FCT  = O_ADFT + SZ_ADFT,          SZ_FCT  = (size_t)2 * 2048 * SEQ * 2;
constexpr size_t O_FO   = O_FCT + SZ_FCT,            SZ_FO   = (size_t)2 * ML * 256 * 4;
constexpr size_t O_WIN  = O_FO + SZ_FO,              SZ_WIN  = (size_t)NZ * D * 2;
constexpr size_t O_LORA = O_WIN + SZ_WIN,            SZ_LORA = (size_t)LN * LK * 2;
constexpr size_t O_PT   = O_LORA + SZ_LORA,          SZ_PT   = (size_t)D * D * 2;
constexpr size_t O_WOT  = O_PT + SZ_PT;
constexpr size_t O_W13  = O_WOT + SZ_PT,             SZ_W13  = (size_t)NE * 4096 * D * 2;
constexpr size_t O_W2T  = O_W13 + SZ_W13,            SZ_W2T  = (size_t)NE * D * EH * 2;
constexpr size_t WS_END = O_W2T + SZ_W2T;
static_assert(WS_END <= (size_t)2048 * MiB, "workspace map must fit 2 GiB");

constexpr int LDS_MAIN = 163584;
constexpr int LDS_MISC = LDS_MAIN;
constexpr int LDS_BYTES = 163840;

__device__ __forceinline__ float bflo(unsigned u) { return __uint_as_float(u << 16); }
__device__ __forceinline__ float bfhi(unsigned u) { return __uint_as_float(u & 0xffff0000u); }
__device__ __forceinline__ float bf1(bf16 v) { return __uint_as_float(((unsigned)v) << 16); }
typedef __bf16 bf16x2_hw __attribute__((ext_vector_type(2)));
__device__ __forceinline__ unsigned pk2(float lo, float hi) { const f32x2 v = (f32x2){lo, hi}; return __builtin_bit_cast(unsigned, __builtin_convertvector(v, bf16x2_hw)); }
__device__ __forceinline__ unsigned f2bf(float f) { return pk2(f, 0.f) & 0xffffu; }
__device__ __forceinline__ float sigmoid_f(float x) { return __builtin_amdgcn_rcpf(1.f + __expf(-x)); }
__device__ __forceinline__ float silu_f(float x) { return x * __builtin_amdgcn_rcpf(1.f + __expf(-x)); }
__device__ __forceinline__ float logsigmoid_f(float x) { return fminf(x, 0.f) - __logf(1.f + __expf(-fabsf(x))); }
__device__ __forceinline__ float wave_sum(float v) {
#pragma unroll
    for (int o = 1; o < 64; o <<= 1) v += __shfl_xor(v, o);
    return v;
}
__device__ __forceinline__ float half_sum(float v) {
#pragma unroll
    for (int o = 1; o < 32; o <<= 1) v += __shfl_xor(v, o);
    return v;
}
template <int CTRL> __device__ __forceinline__ float dpp_mov(float v) { return __builtin_bit_cast(float, __builtin_amdgcn_update_dpp(0, __builtin_bit_cast(int, v), CTRL, 0xF, 0xF, true)); }
template <int N> __device__ __forceinline__ float dpp_shr(float v) { return __builtin_bit_cast(float, __builtin_amdgcn_update_dpp(0, __builtin_bit_cast(int, v), 0x110 + N, 0xF, 0xF, true)); }
__device__ __forceinline__ float row_scan16(float v) { v += dpp_shr<1>(v); v += dpp_shr<2>(v); v += dpp_shr<4>(v); v += dpp_shr<8>(v); return v; }
__device__ __forceinline__ float sum4(float v)  { v += dpp_mov<0xB1>(v); v += dpp_mov<0x4E>(v); return v; }
__device__ __forceinline__ float sum8(float v)  { v = sum4(v); v += dpp_mov<0x141>(v); return v; }
__device__ __forceinline__ float sum16(float v) { v = sum8(v); v += dpp_mov<0x140>(v); return v; }
__device__ __forceinline__ float swap32_add(float a, float b) { const auto r = __builtin_amdgcn_permlane32_swap(__builtin_bit_cast(unsigned, a), __builtin_bit_cast(unsigned, b), false, false); return __builtin_bit_cast(float, (unsigned)r[0]) + __builtin_bit_cast(float, (unsigned)r[1]); }
__device__ __forceinline__ float swap16_add(float a, float b) { const auto r = __builtin_amdgcn_permlane16_swap(__builtin_bit_cast(unsigned, a), __builtin_bit_cast(unsigned, b), false, false); return __builtin_bit_cast(float, (unsigned)r[0]) + __builtin_bit_cast(float, (unsigned)r[1]); }
__device__ __forceinline__ float swap32_max(float a) { const auto r = __builtin_amdgcn_permlane32_swap(__builtin_bit_cast(unsigned, a), __builtin_bit_cast(unsigned, a), false, false); return fmaxf(__builtin_bit_cast(float, (unsigned)r[0]), __builtin_bit_cast(float, (unsigned)r[1])); }
__device__ __forceinline__ float swap16_max(float a) { const auto r = __builtin_amdgcn_permlane16_swap(__builtin_bit_cast(unsigned, a), __builtin_bit_cast(unsigned, a), false, false); return fmaxf(__builtin_bit_cast(float, (unsigned)r[0]), __builtin_bit_cast(float, (unsigned)r[1])); }
__device__ __forceinline__ float half_sum_fast(float v) { v = sum16(v); return swap16_add(v, v); }
__device__ __forceinline__ float rdlane(float v, int l) { return __builtin_bit_cast(float, __builtin_amdgcn_readlane(__builtin_bit_cast(int, v), l)); }
__device__ __forceinline__ float wave_sum_fast(float v) { v = sum16(v); return (rdlane(v, 0) + rdlane(v, 16)) + (rdlane(v, 32) + rdlane(v, 48)); }
__device__ __forceinline__ int mod_index(int r) { return r < ML ? (r >> 12) : 8; }
__device__ __forceinline__ int scan_row(int r, int cm) {
    if (r >= ML || !cm) return r;
    const int t = r & 4095; return (r & ~4095) | ((t & 63) << 6) | (t >> 6);
}

struct Args { const float* in[32]; float* out; unsigned char* ws; int lo, hi; };
struct Ctx {
    float* out; unsigned char* ws; LAS unsigned char* lds;
    int tid, lane, wave, bid, nb;
};
#define LDS_WAIT() asm volatile("s_waitcnt lgkmcnt(0)" ::: "memory")

using pg8::Unit;
typedef f32x4 AccT[2][2][4][2];

struct EpiBf16Store {
    static constexpr bool PERM = true, AFTER_DRAIN = false, HAS_MID = false; static constexpr int MID0 = -1, MID1 = -1;
    bf16* O; int ldc;
    __device__ __forceinline__ void mid(AccT&, const Unit&, int, int, int, int, int) const {}
    __device__ __forceinline__ void operator()(const AccT& acc, const Unit& u, int wr, int wc, int fr, int fq) const {
        const int row0 = u.pm * 256 + wr * 64 + fr, col0 = u.pn * 256 + wc * 32 + 8 * fq;
#pragma unroll
        for (int ai = 0; ai < 2; ++ai)
#pragma unroll
            for (int m = 0; m < 4; ++m) { const int row = row0 + ai * 128 + m * 16; bf16* rowp = O + (size_t)row * ldc + col0;
#pragma unroll
                for (int bj = 0; bj < 2; ++bj) { const f32x4 v0 = acc[ai][bj][m][0], v1 = acc[ai][bj][m][1];
                    u32x4 w; w.x = pg8::cvt_pk_bf16(v0[0], v0[1]); w.y = pg8::cvt_pk_bf16(v0[2], v0[3]); w.z = pg8::cvt_pk_bf16(v1[0], v1[1]); w.w = pg8::cvt_pk_bf16(v1[2], v1[3]);
                    *(u32x4*)(rowp + bj * 128) = w; } }
    }
};
struct EpiZ {
    static constexpr bool PERM = true, AFTER_DRAIN = false, HAS_MID = false; static constexpr int MID0 = -1, MID1 = -1;
    bf16* Z; bf16* FCT; bf16* FCTC; unsigned char* G8;
    __device__ __forceinline__ void mid(AccT&, const Unit&, int, int, int, int, int) const {}
    __device__ __forceinline__ void operator()(const AccT& acc, const Unit& u, int wr, int wc, int fr, int fq) const {
        const int row0 = u.pm * 256 + wr * 64 + fr, col0 = u.pn * 256 + wc * 32 + 8 * fq;
        const bool lat = u.pm < 128;
#pragma unroll
        for (int bj = 0; bj < 2; ++bj) {
            const int c0 = col0 + bj * 128;
            const int kind = ((c0 >= 1920 && c0 < 1984) || (c0 >= 2048 && c0 < 2112)) ? 1 : (c0 >= 2208 && c0 < 2336) ? 2 : (c0 >= ZC_FP && c0 < ZC_GATE) ? 3 : (c0 >= ZC_GATE && c0 < ZC_END) ? 4 : 0;
#pragma unroll
            for (int ai = 0; ai < 2; ++ai)
#pragma unroll
                for (int m = 0; m < 4; ++m) { const int row = row0 + ai * 128 + m * 16;
                    float v[8];
#pragma unroll
                    for (int e = 0; e < 8; ++e) v[e] = acc[ai][bj][m][e >> 2][e & 3];
                    if (kind == 1) {
#pragma unroll
                        for (int e = 0; e < 8; ++e) v[e] = 1.f - 2.f * __builtin_amdgcn_rcpf(1.f + __expf(2.f * v[e]));
                    } else if (kind == 2) {
#pragma unroll
                        for (int e = 0; e < 8; ++e) v[e] = __builtin_amdgcn_rcpf(1.f + __expf(-v[e]));
                    }
                    if (kind == 4) {
                        unsigned lo = 0u, hi = 0u;
#pragma unroll
                        for (int e = 0; e < 4; ++e) { lo = __builtin_amdgcn_cvt_pk_u8_f32(__builtin_rintf(255.f * __builtin_amdgcn_rcpf(1.f + __expf(-v[e]))), e, lo); hi = __builtin_amdgcn_cvt_pk_u8_f32(__builtin_rintf(255.f * __builtin_amdgcn_rcpf(1.f + __expf(-v[e + 4]))), e, hi); }
                        *(u32x2*)(G8 + (size_t)row * 3072 + (c0 - ZC_GATE)) = (u32x2){lo, hi};
                    } else if (kind == 3) {
                        const bool odd = (fr & 1) != 0; const int rc = row - ML;
                        bf16* p = lat ? FCT + ((size_t)((row >> 12) * 256 + (c0 - ZC_FP)) * SEQ + (row & 4095)) : FCTC + ((size_t)((rc >> 8) * 256 + (c0 - ZC_FP)) * CTXL + (rc & 255));
                        const size_t cs = lat ? (size_t)SEQ : (size_t)CTXL;
                        p = odd ? p + cs - 1 : p;
#pragma unroll
                        for (int e2 = 0; e2 < 4; ++e2) { const float a = v[2 * e2], bq = v[2 * e2 + 1], an = dpp_mov<0xB1>(a), bn = dpp_mov<0xB1>(bq);
                            *(unsigned*)(p + (size_t)(2 * e2) * cs) = odd ? pk2(bn, bq) : pk2(a, an); }
                    } else {
                        u32x4 w; w.x = pg8::cvt_pk_bf16(v[0], v[1]); w.y = pg8::cvt_pk_bf16(v[2], v[3]); w.z = pg8::cvt_pk_bf16(v[4], v[5]); w.w = pg8::cvt_pk_bf16(v[6], v[7]);
                        *(u32x4*)(Z + (size_t)row * NZ + c0) = w;
                    } }
        }
    }
};
struct EpiExpertOut {
    static constexpr bool PERM = true, AFTER_DRAIN = false, HAS_MID = false; static constexpr int MID0 = -1, MID1 = -1;
    bf16* O; const float* gate;
    __device__ __forceinline__ void mid(AccT&, const Unit&, int, int, int, int, int) const {}
    __device__ __forceinline__ void operator()(const AccT& acc, const Unit& u, int wr, int wc, int fr, int fq) const {
        const int row0 = u.pm * 256 + wr * 64 + fr, col0 = (u.pn & 3) * 256 + wc * 32 + 8 * fq;
        float gs[2][4];
#pragma unroll
        for (int ai = 0; ai < 2; ++ai)
#pragma unroll
            for (int m = 0; m < 4; ++m) gs[ai][m] = gate[row0 + ai * 128 + m * 16];
#pragma unroll
        for (int ai = 0; ai < 2; ++ai)
#pragma unroll
            for (int m = 0; m < 4; ++m) { const int row = row0 + ai * 128 + m * 16; bf16* rowp = O + (size_t)row * D + col0; const float s = gs[ai][m];
#pragma unroll
                for (int bj = 0; bj < 2; ++bj) { const f32x4 v0 = acc[ai][bj][m][0] * s, v1 = acc[ai][bj][m][1] * s;
                    u32x4 w; w.x = pg8::cvt_pk_bf16(v0[0], v0[1]); w.y = pg8::cvt_pk_bf16(v0[2], v0[3]); w.z = pg8::cvt_pk_bf16(v1[0], v1[1]); w.w = pg8::cvt_pk_bf16(v1[2], v1[3]);
                    *(u32x4*)(rowp + bj * 128) = w; } }
    }
};
struct EpiHid {
    static constexpr bool PERM = true, AFTER_DRAIN = false, HAS_MID = false; static constexpr int MID0 = -1, MID1 = -1;
    bf16* O;
    __device__ __forceinline__ void mid(AccT&, const Unit&, int, int, int, int, int) const {}
    __device__ __forceinline__ void operator()(const AccT& acc, const Unit& u, int wr, int wc, int fr, int fq) const {
        const int row0 = u.pm * 256 + wr * 64 + fr, col0 = (u.pn & 15) * 128 + wc * 32 + 8 * fq;
#pragma unroll
        for (int ai = 0; ai < 2; ++ai)
#pragma unroll
            for (int m = 0; m < 4; ++m) { bf16* rowp = O + (size_t)(row0 + ai * 128 + m * 16) * EH + col0;
                float h[8];
#pragma unroll
                for (int n = 0; n < 2; ++n)
#pragma unroll
                    for (int j = 0; j < 4; ++j) h[n * 4 + j] = silu_f(acc[ai][0][m][n][j]) * acc[ai][1][m][n][j];
                u32x4 w; w.x = pg8::cvt_pk_bf16(h[0], h[1]); w.y = pg8::cvt_pk_bf16(h[2], h[3]); w.z = pg8::cvt_pk_bf16(h[4], h[5]); w.w = pg8::cvt_pk_bf16(h[6], h[7]);
                *(u32x4*)rowp = w; }
    }
};
struct EpiMerge3 {
    static constexpr bool PERM = true, AFTER_DRAIN = false, HAS_MID = false; static constexpr int MID0 = -1, MID1 = -1;
    bf16* O; const unsigned char* G8;
    __device__ __forceinline__ void mid(AccT&, const Unit&, int, int, int, int, int) const {}
    __device__ __forceinline__ void operator()(const AccT& acc, const Unit& u, int wr, int wc, int fr, int fq) const {
        int row0 = u.pm * 256 + wr * 64 + fr; asm volatile("" : "+v"(row0));
        const int col0 = u.pn * 256 + wc * 32 + 8 * fq, br = u.aux;
        const char* zb = (const char*)G8; char* ob = (char*)O;
        const unsigned zoff = (unsigned)(1024 * br + col0);
        u32x2 gz[2][4][2];
#pragma unroll
        for (int ai = 0; ai < 2; ++ai)
#pragma unroll
            for (int m = 0; m < 4; ++m) { const unsigned row = (unsigned)(row0 + ai * 128 + m * 16);
#pragma unroll
                for (int bj = 0; bj < 2; ++bj) gz[ai][m][bj] = *(const u32x2*)(zb + row * 3072u + zoff + bj * 128); }
#pragma unroll
        for (int ai = 0; ai < 2; ++ai) {
            u32x4 mo[4][2];
#pragma unroll
            for (int m = 0; m < 4; ++m) { const unsigned row = (unsigned)(row0 + ai * 128 + m * 16);
#pragma unroll
                for (int bj = 0; bj < 2; ++bj) { if (br) mo[m][bj] = *(const u32x4*)(ob + row * (unsigned)(D * 2) + (unsigned)col0 * 2u + bj * 256); else mo[m][bj] = (u32x4){0u, 0u, 0u, 0u}; } }
#pragma unroll
            for (int m = 0; m < 4; ++m) { const unsigned row = (unsigned)(row0 + ai * 128 + m * 16);
#pragma unroll
                for (int bj = 0; bj < 2; ++bj) { float h[8];
#pragma unroll
                    for (int q = 0; q < 4; ++q) { const unsigned gw_ = gz[ai][m][bj][q >> 1] >> (16 * (q & 1));
                        h[2 * q] = acc[ai][bj][m][q >> 1][(q & 1) * 2] * (float)(gw_ & 0xffu) + bflo(mo[m][bj][q]); h[2 * q + 1] = acc[ai][bj][m][q >> 1][(q & 1) * 2 + 1] * (float)((gw_ >> 8) & 0xffu) + bfhi(mo[m][bj][q]); }
                    u32x4 w; w.x = pg8::cvt_pk_bf16(h[0], h[1]); w.y = pg8::cvt_pk_bf16(h[2], h[3]); w.z = pg8::cvt_pk_bf16(h[4], h[5]); w.w = pg8::cvt_pk_bf16(h[6], h[7]);
                    *(u32x4*)(ob + row * (unsigned)(D * 2) + (unsigned)col0 * 2u + bj * 256) = w; } }
            asm volatile("" ::: "memory");
        }
    }
};
struct EpiResid {
    static constexpr bool PERM = true, AFTER_DRAIN = false, HAS_MID = false; static constexpr int MID0 = -1, MID1 = -1;
    bf16* H; const float* modl;
    __device__ __forceinline__ void mid(AccT&, const Unit&, int, int, int, int, int) const {}
    __device__ __forceinline__ void operator()(const AccT& acc, const Unit& u, int wr, int wc, int fr, int fq) const {
        const int row0 = u.pm * 256 + wr * 64 + fr, col0 = u.pn * 256 + wc * 32 + 8 * fq;
        const int mi = u.pm < 128 ? (u.pm >> 4) : 8;
        const float* g = modl + (size_t)mi * 6144 + 2048 + col0;
        f32x4 gv[2][2];
#pragma unroll
        for (int bj = 0; bj < 2; ++bj)
#pragma unroll
            for (int n = 0; n < 2; ++n) gv[bj][n] = *(const f32x4*)(g + bj * 128 + n * 4);
        u32x4 hv[2][4][2];
#pragma unroll
        for (int ai = 0; ai < 2; ++ai)
#pragma unroll
            for (int m = 0; m < 4; ++m)
#pragma unroll
                for (int bj = 0; bj < 2; ++bj) hv[ai][m][bj] = *(const u32x4*)(H + (size_t)(row0 + ai * 128 + m * 16) * D + col0 + bj * 128);
#pragma unroll
        for (int ai = 0; ai < 2; ++ai) {
#pragma unroll
            for (int m = 0; m < 4; ++m)
#pragma unroll
                for (int bj = 0; bj < 2; ++bj) { const f32x4 a0 = acc[ai][bj][m][0] * gv[bj][0], a1 = acc[ai][bj][m][1] * gv[bj][1]; const u32x4 o = hv[ai][m][bj];
                    u32x4 w; w.x = pk2(bflo(o.x) + a0[0], bfhi(o.x) + a0[1]); w.y = pk2(bflo(o.y) + a0[2], bfhi(o.y) + a0[3]); w.z = pk2(bflo(o.z) + a1[0], bfhi(o.z) + a1[1]); w.w = pk2(bflo(o.w) + a1[2], bfhi(o.w) + a1[3]);
                    *(u32x4*)(H + (size_t)(row0 + ai * 128 + m * 16) * D + col0 + bj * 128) = w; }
        }
    }
};
struct EpiDft {
    static constexpr bool PERM = false, AFTER_DRAIN = false, HAS_MID = false; static constexpr int MID0 = -1, MID1 = -1;
    bf16* FO; int ctx;
    __device__ __forceinline__ void mid(AccT&, const Unit&, int, int, int, int, int) const {}
    __device__ __forceinline__ void operator()(const AccT& acc, const Unit& u, int wr, int wc, int fr, int fq) const {
        const int part = ctx ? u.pm : (u.pm >> 4), pml = u.pm & 15, b = u.pn & 7;
        const int row0 = (ctx ? ML + b * CTXL : b * 4096 + pml * 256) + wr * 64 + fr, col0 = wc * 32 + 4 * fq;
        bf16* base = FO + (size_t)part * MT * 256;
#pragma unroll
        for (int ai = 0; ai < 2; ++ai)
#pragma unroll
            for (int m = 0; m < 4; ++m) { bf16* rowp = base + (size_t)(row0 + ai * 128 + m * 16) * 256 + col0;
#pragma unroll
                for (int bj = 0; bj < 2; ++bj)
#pragma unroll
                    for (int n = 0; n < 2; ++n) { const f32x4 v = acc[ai][bj][m][n]; *(u32x2*)(rowp + bj * 128 + n * 16) = (u32x2){pg8::cvt_pk_bf16(v[0], v[1]), pg8::cvt_pk_bf16(v[2], v[3])}; } }
    }
};

__device__ __forceinline__ void phase_prologue(const Ctx& X, const Args& A) {
    LAS float* sv = (LAS float*)X.lds;
    LAS float* red = sv + 9 * 1024;
    for (int i = X.tid; i < 9 * 1024; i += NTHR) { const float v = i < 8 * 1024 ? A.in[1][i] : A.in[3][i - 8 * 1024]; sv[i] = silu_f(v); }
    __syncthreads();
    float* MOD = (float*)(X.ws + O_MOD);
    for (int it = X.bid; it < DEPTH * 24; it += X.nb) {
        const int l = it / 24, cb = (it % 24) * 256;
        const float* w = A.in[4] + (size_t)l * D * 6144 + cb + 4 * X.lane;
        f32x4 acc[9];
#pragma unroll
        for (int i = 0; i < 9; ++i) acc[i] = (f32x4){0.f, 0.f, 0.f, 0.f};
        const int k0 = X.wave * 128;
#pragma unroll 2
        for (int k = k0; k < k0 + 128; k += 4) {
            f32x4 wv[4], sq[9];
#pragma unroll
            for (int kk = 0; kk < 4; ++kk) wv[kk] = *(const f32x4*)(w + (size_t)(k + kk) * 6144);
#pragma unroll
            for (int i = 0; i < 9; ++i) sq[i] = *(const LAS f32x4*)(sv + i * 1024 + k);
#pragma unroll
            for (int kk = 0; kk < 4; ++kk)
#pragma unroll
                for (int i = 0; i < 9; ++i) acc[i] += wv[kk] * sq[i][kk]; }
#pragma unroll
        for (int i = 0; i < 9; ++i) *(LAS f32x4*)(red + (X.wave * 9 + i) * 256 + 4 * X.lane) = acc[i];
        __syncthreads();
        for (int o = X.tid; o < 9 * 256; o += NTHR) { const int i = o >> 8, c = o & 255; float sm = A.in[5][(size_t)l * 6144 + cb + c];
#pragma unroll
            for (int wv = 0; wv < NWAVE; ++wv) sm += red[(wv * 9 + i) * 256 + c];
            MOD[((size_t)l * 9 + i) * 6144 + cb + c] = sm; }
        __syncthreads();
    }
    { LAS float* ct = (LAS float*)X.lds; LAS float* st = ct + 4096;
      __syncthreads();
      for (int i = X.tid; i < 4096; i += NTHR) { float sn, cs; sincospif((float)i * (1.f / 2048.f), &sn, &cs); ct[i] = cs * (1.f / 512.f); st[i] = -sn * (1.f / 512.f); }
      __syncthreads();
      bf16* A = (bf16*)(X.ws + O_ADFT);
      const size_t total = (size_t)SEQ * SEQ / 2;
      for (size_t i = (size_t)X.bid * NTHR + X.tid; i < total; i += (size_t)X.nb * NTHR) {
          const int tp = (int)(i >> 11), t = (int)(i & 2047) * 2;
          const int p0 = (tp * t) & 4095, p1 = (p0 + tp) & 4095;
          *(unsigned*)(A + (size_t)tp * SEQ + t) = pk2(ct[p0], ct[p1]);
          *(unsigned*)(A + (size_t)SEQ * SEQ + (size_t)tp * SEQ + t) = pk2(st[p0], st[p1]); }
      bf16* AC = (bf16*)(X.ws + O_ADFTC);
      for (int i = X.bid * NTHR + X.tid; i < CTXL * CTXL / 2; i += X.nb * NTHR) {
          const int tp = i >> 7, t = (i & 127) * 2;
          const int p0 = (tp * t) & 255, p1 = (p0 + tp) & 255;
          *(unsigned*)(AC + tp * CTXL + t) = pk2(4.f * ct[16 * p0], 4.f * ct[16 * p1]);
          *(unsigned*)(AC + CTXL * CTXL + tp * CTXL + t) = pk2(4.f * st[16 * p0], 4.f * st[16 * p1]); }
      __syncthreads(); }
    { u32x2* H = (u32x2*)(X.ws + O_H); const f32x4* x = (const f32x4*)A.in[0]; const f32x4* cx = (const f32x4*)A.in[2];
      const size_t nl = (size_t)ML * D / 4, nt = (size_t)MT * D / 4;
      for (size_t i = (size_t)X.bid * NTHR + X.tid; i < nt; i += (size_t)X.nb * NTHR) { const f32x4 v = i < nl ? x[i] : cx[i - nl]; H[i] = (u32x2){pk2(v.x, v.y), pk2(v.z, v.w)}; } }
}

__device__ __forceinline__ void tr_item(const float* W, int N, int k0, int n0, bf16* dst, int ld, int row0, int kdst, LAS float* scr, int lane) {
    float tv[32]; const unsigned loff = (unsigned)((lane >> 5) * N + (lane & 31));
#pragma unroll
    for (int i = 0; i < 32; ++i) { const float* rowp = W + (size_t)(k0 + 2 * i) * N + n0; tv[i] = rowp[loff]; }
#pragma unroll
    for (int i = 0; i < 32; ++i) scr[(2 * i + (lane >> 5)) * 33 + (lane & 31)] = tv[i];
    LDS_WAIT(); asm volatile("" ::: "memory");
    const int c = lane & 7;
#pragma unroll
    for (int j = 0; j < 4; ++j) { const int n = (lane >> 3) + 8 * j; const LAS float* s = scr + (8 * c) * 33 + n;
        u32x4 o; o.x = pk2(s[0 * 33], s[1 * 33]); o.y = pk2(s[2 * 33], s[3 * 33]); o.z = pk2(s[4 * 33], s[5 * 33]); o.w = pk2(s[6 * 33], s[7 * 33]);
        *(u32x4*)(dst + (size_t)(row0 + n) * ld + kdst + 8 * c) = o; }
    LDS_WAIT(); asm volatile("" ::: "memory");
}
__device__ __forceinline__ void phase_weights(const Ctx& X, const Args& A, int layer) {
    LAS float* scr = (LAS float*)(X.lds + X.wave * 8704);
    const int gw = X.bid * NWAVE + X.wave, NGW = X.nb * NWAVE;
    bf16* WIN = (bf16*)(X.ws + O_WIN); bf16* PT = (bf16*)(X.ws + O_PT); bf16* WOT = (bf16*)(X.ws + O_WOT);
    constexpr int I_WIN = 16 * 189, I_PA = 6 * 32, I_PC = 4 * 32, I_WO = 16 * 32;
    constexpr int NITEMS = I_WIN + 2 * I_PA + I_PC + I_WO;
    for (int it = gw; it < NITEMS; it += NGW) {
        int r = it;
        if (r < I_WIN) { const int kb = r / 189, nbk = r % 189, n0 = 32 * nbk;
            if (n0 < SRC_FN || n0 >= SRC_GATE) { const int d0 = n0 < 1984 ? n0 : n0 < 2048 ? n0 + 64 : n0 < 2112 ? n0 - 64 : n0 < SRC_FN ? n0 : n0 + (ZC_GATE - SRC_GATE);
                tr_item(A.in[8] + (size_t)layer * D * INCOLS, INCOLS, 64 * kb, n0, WIN, D, d0, 64 * kb, scr, X.lane); }
            continue; } r -= I_WIN;
        if (r < I_PA) { const int kb = r / 32, nbk = r % 32; tr_item(A.in[23] + (size_t)layer * RW * D, D, 64 * kb, 32 * nbk, PT, D, 32 * nbk, 64 * kb, scr, X.lane); continue; } r -= I_PA;
        if (r < I_PA) { const int kb = r / 32, nbk = r % 32; tr_item(A.in[24] + (size_t)layer * GVW * D, D, 64 * kb, 32 * nbk, PT, D, 32 * nbk, 384 + 64 * kb, scr, X.lane); continue; } r -= I_PA;
        if (r < I_PC) { const int kb = r / 32, nbk = r % 32; tr_item(A.in[25] + (size_t)layer * FNW * D, D, 64 * kb, 32 * nbk, PT, D, 32 * nbk, 768 + 64 * kb, scr, X.lane); continue; } r -= I_PC;
        { const int kb = r / 32, nbk = r % 32; tr_item(A.in[26] + (size_t)layer * D * D, D, 64 * kb, 32 * nbk, WOT, D, 32 * nbk, 64 * kb, scr, X.lane); }
    }
    { unsigned* z = (unsigned*)(WIN + (size_t)ZC_END * D); const int n = (NZ - ZC_END) * D / 2;
      for (int i = X.bid * NTHR + X.tid; i < n; i += X.nb * NTHR) z[i] = 0u; }
    { LAS float* tab = (LAS float*)(X.lds + 8 * 8704);
      if (X.tid < 64) { float sn, cs; sincospif((float)X.tid * (1.f / 32.f), &sn, &cs); tab[X.tid] = cs; tab[64 + X.tid] = sn; }
      __syncthreads();
      const float* wsrc = A.in[8] + (size_t)layer * D * INCOLS + SRC_FN;
      for (int i = X.bid * NTHR + X.tid; i < 256 * D; i += X.nb * NTHR) { const int n2 = i >> 10, k = i & 1023, g = n2 >> 6, j = n2 & 63, cp = j <= 32 ? j : j - 32;
          const float* wr = wsrc + (size_t)k * INCOLS + g * 64; const LAS float* tb = tab + (j <= 32 ? 0 : 64); float acc = 0.f;
          for (int c = 0; c < 64; c += 4) { const f32x4 wv = *(const f32x4*)(wr + c);
              acc += wv.x * tb[(c * cp) & 63] + wv.y * tb[((c + 1) * cp) & 63] + wv.z * tb[((c + 2) * cp) & 63] + wv.w * tb[((c + 3) * cp) & 63]; }
          WIN[(size_t)(ZC_FP + n2) * D + k] = (bf16)f2bf(acc); } }
    { bf16* LT = (bf16*)(X.ws + O_LORA);
      const float* wup = A.in[11] + (size_t)layer * 2 * 64 * RW; const float* aup = A.in[13] + (size_t)layer * 2 * 64 * RW;
      const float* gup = A.in[20] + (size_t)layer * 2 * 16 * GKW; const float* rgu = A.in[17] + (size_t)layer * 128 * RW;
      for (int i = X.bid * NTHR + X.tid; i < LN * LK; i += X.nb * NTHR) {
          const int n = i / LK, k = i % LK; float v = 0.f;
          if (n < 384)       { if (k < 64) v = wup[(size_t)k * RW + n]; }
          else if (n < 768)  { if (k >= 64 && k < 128) v = aup[(size_t)(k - 64) * RW + (n - 384)]; }
          else if (n < 1152) { if (k >= 128 && k < 192) v = wup[(size_t)(64 + k - 128) * RW + (n - 768)]; }
          else if (n < 1536) { if (k >= 192 && k < 256) v = aup[(size_t)(64 + k - 192) * RW + (n - 1152)]; }
          else if (n < 1728) { if (k >= 256 && k < 272) v = gup[(size_t)(k - 256) * GKW + (n - 1536)]; }
          else if (n < 1920) { if (k >= 272 && k < 288) v = gup[(size_t)(16 + k - 272) * GKW + (n - 1728)]; }
          else               { if (k >= 288 && k < 416) v = rgu[(size_t)(k - 288) * RW + (n - 1920)]; }
          LT[i] = (bf16)f2bf(v); } }
}

template <bool FINAL>
__device__ __forceinline__ void phase_norm1(const Ctx& X, const Args& A, int layer) {
    const int gw = X.bid * NWAVE + X.wave, NGW = X.nb * NWAVE, lane = X.lane;
    bf16* H = (bf16*)(X.ws + O_H); bf16* U = (bf16*)(X.ws + O_U); const float* MOD = (const float*)(X.ws + O_MOD);
    const int* SEL = (const int*)(X.ws + O_SEL); const bf16* YS = (const bf16*)(X.ws + O_XS);
    const float* nw = FINAL ? A.in[31] : A.in[6] + (size_t)layer * D;
    const int npair = (FINAL ? ML : MT) >> 1;
    u32x2 hw[2][4]; int sv[2] = {-1, -1};
    if (gw < npair) {
#pragma unroll
        for (int q = 0; q < 2; ++q) {
#pragma unroll
            for (int j = 0; j < 4; ++j) hw[q][j] = *(const u32x2*)(H + (size_t)(2 * gw + q) * D + 4 * lane + 256 * j);
            if (layer > 0) sv[q] = SEL[(size_t)(2 * gw + q) * NE + (lane & 15)]; } }
    for (int p = gw; p < npair; p += NGW) {
        const int r0 = 2 * p, mi = mod_index(r0);
        f32x4 h[2][4];
#pragma unroll
        for (int q = 0; q < 2; ++q)
#pragma unroll
            for (int j = 0; j < 4; ++j) h[q][j] = (f32x4){bflo(hw[q][j].x), bfhi(hw[q][j].x), bflo(hw[q][j].y), bfhi(hw[q][j].y)};
        const int sv0 = sv[0], sv1 = sv[1];
        if (p + NGW < npair) { const int rn = 2 * (p + NGW);
#pragma unroll
            for (int q = 0; q < 2; ++q) {
#pragma unroll
                for (int j = 0; j < 4; ++j) hw[q][j] = *(const u32x2*)(H + (size_t)(rn + q) * D + 4 * lane + 256 * j);
                if (layer > 0) sv[q] = SEL[(size_t)(rn + q) * NE + (lane & 15)]; } }
        if (layer > 0) {
            const float* g2 = MOD + ((size_t)(layer - 1) * 9 + mi) * 6144 + 5120 + 4 * lane;
            unsigned long long m0 = __ballot(sv0 >= 0) & 0xffffull, m1 = __ballot(sv1 >= 0) & 0xffffull;
            f32x4 a[2][4];
#pragma unroll
            for (int q = 0; q < 2; ++q)
#pragma unroll
                for (int j = 0; j < 4; ++j) a[q][j] = (f32x4){0.f, 0.f, 0.f, 0.f};
            while (m0 | m1) {
                int sl[4]; u32x2 yw[4][4];
#pragma unroll
                for (int k = 0; k < 2; ++k) { if (m0) { const int e = __builtin_ctzll(m0); m0 &= m0 - 1; sl[k] = __builtin_amdgcn_readlane(sv0, e); } else sl[k] = -1; }
#pragma unroll
                for (int k = 2; k < 4; ++k) { if (m1) { const int e = __builtin_ctzll(m1); m1 &= m1 - 1; sl[k] = __builtin_amdgcn_readlane(sv1, e); } else sl[k] = -1; }
#pragma unroll
                for (int k = 0; k < 4; ++k) if (sl[k] >= 0) {
#pragma unroll
                    for (int j = 0; j < 4; ++j) yw[k][j] = *(const u32x2*)(YS + (size_t)sl[k] * D + 4 * lane + 256 * j); }
#pragma unroll
                for (int k = 0; k < 4; ++k) if (sl[k] >= 0) {
#pragma unroll
                    for (int j = 0; j < 4; ++j) a[k >> 1][j] += (f32x4){bflo(yw[k][j].x), bfhi(yw[k][j].x), bflo(yw[k][j].y), bfhi(yw[k][j].y)}; }
            }
#pragma unroll
            for (int j = 0; j < 4; ++j) { const f32x4 g = *(const f32x4*)(g2 + 256 * j);
#pragma unroll
                for (int q = 0; q < 2; ++q) { h[q][j] = h[q][j] + g * a[q][j]; if (!FINAL) *(u32x2*)(H + (size_t)(r0 + q) * D + 4 * lane + 256 * j) = (u32x2){pk2(h[q][j].x, h[q][j].y), pk2(h[q][j].z, h[q][j].w)}; } }
        }
        float rs[2];
#pragma unroll
        for (int q = 0; q < 2; ++q) { float ss = 0.f;
#pragma unroll
            for (int j = 0; j < 4; ++j) ss += (h[q][j].x * h[q][j].x + h[q][j].y * h[q][j].y) + (h[q][j].z * h[q][j].z + h[q][j].w * h[q][j].w);
            rs[q] = __builtin_amdgcn_rsqf(wave_sum_fast(ss) * (1.f / D) + NORM_EPS); }
        if (FINAL) {
#pragma unroll
            for (int j = 0; j < 4; ++j) { const f32x4 w = *(const f32x4*)(nw + 4 * lane + 256 * j);
#pragma unroll
                for (int q = 0; q < 2; ++q) *(f32x4*)(X.out + (size_t)(r0 + q) * D + 4 * lane + 256 * j) = h[q][j] * rs[q] * w; }
        } else {
            const float* md = MOD + ((size_t)layer * 9 + mi) * 6144 + 4 * lane;
#pragma unroll
            for (int j = 0; j < 4; ++j) { const f32x4 w = *(const f32x4*)(nw + 4 * lane + 256 * j), sh = *(const f32x4*)(md + 256 * j), sc = *(const f32x4*)(md + 1024 + 256 * j); const f32x4 wsc = w * (sc + 1.f);
#pragma unroll
                for (int q = 0; q < 2; ++q) { const f32x4 u = h[q][j] * rs[q] * wsc + sh; *(u32x2*)(U + (size_t)(r0 + q) * D + 4 * lane + 256 * j) = (u32x2){pk2(u.x, u.y), pk2(u.z, u.w)}; } }
        }
    }
}

__device__ __forceinline__ void conv_emit(unsigned char* ws, f32x4 a, const unsigned off, const int kind, const f32x4 kw, const float sc) {
    if (kind >= 3) a = (f32x4){silu_f(a.x), silu_f(a.y), silu_f(a.z), silu_f(a.w)} * sc;
    *(u32x2*)(ws + off) = (u32x2){pk2(a.x, a.y), pk2(a.z, a.w)};
    if (kind == 1) { const f32x4 kb = a * kw; const float ss = sum16((kb.x * kb.x + kb.y * kb.y) + (kb.z * kb.z + kb.w * kb.w));
        const float inv = __builtin_amdgcn_rsqf(fmaxf(ss, 1e-24f));
        *(u32x2*)(ws + (off + (unsigned)(O_RKK - O_KT))) = (u32x2){pk2(kb.x * inv, kb.y * inv), pk2(kb.z * inv, kb.w * inv)}; }
}
__device__ __forceinline__ f32x4 bf4(const u32x2 z) { return (f32x4){bflo(z.x), bfhi(z.x), bflo(z.y), bfhi(z.y)}; }
__device__ __forceinline__ void conv_dest(const int c, int& kind, unsigned& dst0, unsigned& stride, float& sc) {
    kind = c < ZC_K ? 0 : c < ZC_V ? 1 : c < ZC_GQ ? 2 : c < ZC_GK ? 3 : c < ZC_GV ? 4 : 5;
    dst0 = kind == 0 ? (unsigned)O_RR + 2u * c : kind == 1 ? (unsigned)O_KT + 2u * (c - ZC_K) : kind == 2 ? (unsigned)O_RV + 2u * (c - ZC_V) : kind == 3 ? (unsigned)O_GQ + 2u * (c - ZC_GQ) : kind == 4 ? (unsigned)O_GK + 2u * (c - ZC_GK) : (unsigned)O_GV + 2u * (c - ZC_GV);
    stride = (kind == 3 || kind == 4) ? 2u * GKW : 2u * RW; sc = (kind == 3) ? 0.14433756729740643f : 1.f;
}
__device__ __forceinline__ void phase_conv(const Ctx& X, const Args& A, int layer) {
    const int cm = layer & 1, lane = X.lane;
    const int gw = X.bid * NWAVE + X.wave, NGW = X.nb * NWAVE;
    const bf16* Z = (const bf16*)(X.ws + O_Z);
    const float* cwl = A.in[9] + (size_t)layer * 9 * CONVC; const float* kkw = A.in[14] + (size_t)layer * RW;
    constexpr int CONV_RB = 16, NBAND = 64 / CONV_RB, CONV_CW = 8, NSEG = 64 / CONV_CW;
    for (int it = gw; it < NB * NBAND * 8 * NSEG; it += NGW) {
        const int seg = it % NSEG, jj = (it / NSEG) & 7, band = (it / (8 * NSEG)) % NBAND, b = it / (8 * NSEG * NBAND);
        const int c = 4 * lane + 256 * jj;
        if (c >= CONVC) continue;
        const int colbase = seg * CONV_CW, g0 = band * CONV_RB;
        f32x4 w[9];
#pragma unroll
        for (int tap = 0; tap < 9; ++tap) w[tap] = *(const f32x4*)(cwl + tap * CONVC + c);
        int kind; unsigned dst0, stride; float sc; conv_dest(c, kind, dst0, stride, sc);
        const unsigned step = cm ? 64u * stride : stride;
        f32x4 kw = (f32x4){0.f, 0.f, 0.f, 0.f}; if (kind == 1) kw = *(const f32x4*)(kkw + (c - ZC_K));
        u32x2 za[CONV_CW + 2], zb[CONV_CW + 2], zc[CONV_CW + 2], zd[CONV_CW + 2];
#define CONV_ROW(dst, gr_) do { const int g_ = (gr_); const bool rv_ = g_ >= 0 && g_ < 64; const bf16* zr_ = Z + ((size_t)(b * SEQ + g_ * 64 + colbase) - 1) * NZ + c; \
        _Pragma("unroll") for (int x = 0; x < CONV_CW + 2; ++x) { const int p_ = colbase + x - 1; const bool ok_ = rv_ && p_ >= 0 && p_ < 64; dst[x] = ok_ ? *(const u32x2*)(zr_ + (size_t)x * NZ) : (u32x2){0u, 0u}; } } while (0)
#define CONV_OUT(ZA, ZB, ZC, gr_) do { const int go_ = (gr_); const unsigned offb_ = dst0 + (unsigned)(cm ? b * SEQ + colbase * 64 + go_ : b * SEQ + go_ * 64 + colbase) * stride; \
        _Pragma("unroll") for (int xo = 0; xo < CONV_CW; ++xo) { f32x4 a = (f32x4){0.f, 0.f, 0.f, 0.f}; \
            _Pragma("unroll") for (int dx = 0; dx < 3; ++dx) { a += bf4(ZA[xo + dx]) * w[dx]; a += bf4(ZB[xo + dx]) * w[3 + dx]; a += bf4(ZC[xo + dx]) * w[6 + dx]; } \
            conv_emit(X.ws, a, offb_ + (unsigned)xo * step, kind, kw, sc); } } while (0)
        CONV_ROW(za, g0 - 1); CONV_ROW(zb, g0); CONV_ROW(zc, g0 + 1);
#pragma unroll 1
        for (int k = 0; k < CONV_RB; k += 4) { const int gr = g0 + k;
            CONV_ROW(zd, gr + 2); CONV_OUT(za, zb, zc, gr);
            CONV_ROW(za, gr + 3); CONV_OUT(zb, zc, zd, gr + 1);
            CONV_ROW(zb, gr + 4); CONV_OUT(zc, zd, za, gr + 2);
            CONV_ROW(zc, (k + 4 < CONV_RB) ? gr + 5 : 64); CONV_OUT(zd, za, zb, gr + 3);
        }
#undef CONV_ROW
#undef CONV_OUT
    }
    for (int it = gw; it < (MC / 64) * 8 * 4; it += NGW) {
        const int seg = it & 3, jj = (it >> 2) & 7, s2 = it >> 5;
        const int c = 4 * lane + 256 * jj;
        if (c >= CONVC) continue;
        const int colbase = seg * 16, b = s2 >> 2, sg = s2 & 3, r0 = ML + b * CTXL + sg * 64 + colbase, lo = -sg * 64, hi = CTXL - sg * 64;
        f32x4 w[3];
#pragma unroll
        for (int dx = 0; dx < 3; ++dx) w[dx] = *(const f32x4*)(cwl + (3 + dx) * CONVC + c);
        u32x2 zz[18];
#pragma unroll
        for (int x = 0; x < 18; ++x) { const int p = colbase + x - 1; const bool ok = p >= lo && p < hi; zz[x] = ok ? *(const u32x2*)(Z + (size_t)(r0 + x - 1) * NZ + c) : (u32x2){0u, 0u}; }
        int kind; unsigned dst0, stride; float sc; conv_dest(c, kind, dst0, stride, sc);
        f32x4 kw = (f32x4){0.f, 0.f, 0.f, 0.f}; if (kind == 1) kw = *(const f32x4*)(kkw + (c - ZC_K));
        const unsigned offb = dst0 + (unsigned)r0 * stride;
#pragma unroll
        for (int xo = 0; xo < 16; ++xo) {
            f32x4 a = (f32x4){0.f, 0.f, 0.f, 0.f};
#pragma unroll
            for (int dx = 0; dx < 3; ++dx) a += bf4(zz[xo + dx]) * w[dx];
            conv_emit(X.ws, a, offb + (unsigned)xo * stride, kind, kw, sc); }
    }
}

__device__ __forceinline__ int chain_row(int dir, int b, int s) {
    if (s < CTXL) return ML + b * CTXL + (dir ? (CTXL - 1 - s) : s);
    const int p = s - CTXL; return b * SEQ + (dir ? (SEQ - 1 - p) : p);
}
constexpr int WEXP_ITEMS = 3 * 1024 * NE;
struct WexpLoc { const float* W; bf16* dst; int N, k0, n0, ld, row0; };
__device__ __forceinline__ WexpLoc wexp_locate(const Ctx& X, const Args& A, int layer, int r) {
    WexpLoc L; constexpr int I_E = 1024 * NE;
    if (r < 2 * I_E) { const int which = r / I_E; r -= which * I_E; const int e = r >> 10, q = r & 1023, kb = q >> 6, nbk = q & 63, n0 = 32 * nbk;
        L.W = A.in[which ? 29 : 28] + ((size_t)layer * NE + e) * D * EH; L.N = EH; L.k0 = 64 * kb; L.n0 = n0; L.dst = (bf16*)(X.ws + O_W13) + (size_t)e * 4096 * D; L.ld = D; L.row0 = (n0 >> 7) * 256 + (n0 & 127) + which * 128; }
    else { r -= 2 * I_E; const int e = r >> 10, q = r & 1023, kb = q >> 5, nbk = q & 31;
        L.W = A.in[30] + ((size_t)layer * NE + e) * EH * D; L.N = D; L.k0 = 64 * kb; L.n0 = 32 * nbk; L.dst = (bf16*)(X.ws + O_W2T) + (size_t)e * D * EH; L.ld = EH; L.row0 = 32 * nbk; }
    return L;
}
__device__ __forceinline__ void wexp_issue(const WexpLoc& L, int lane, float (&tv)[32]) {
    const unsigned loff = (unsigned)((lane >> 5) * L.N + (lane & 31));
#pragma unroll
    for (int i = 0; i < 32; ++i) { const float* rowp = L.W + (size_t)(L.k0 + 2 * i) * L.N + L.n0; tv[i] = rowp[loff]; }
}
__device__ __forceinline__ void wexp_finish(const WexpLoc& L, int lane, const float (&tv)[32], LAS float* scr) {
#pragma unroll
    for (int i = 0; i < 32; ++i) scr[(2 * i + (lane >> 5)) * 33 + (lane & 31)] = tv[i];
    LDS_WAIT(); asm volatile("" ::: "memory");
    const int c = lane & 7;
#pragma unroll
    for (int j = 0; j < 4; ++j) { const int n = (lane >> 3) + 8 * j; const LAS float* sp = scr + (8 * c) * 33 + n;
        u32x4 o; o.x = pk2(sp[0 * 33], sp[1 * 33]); o.y = pk2(sp[2 * 33], sp[3 * 33]); o.z = pk2(sp[4 * 33], sp[5 * 33]); o.w = pk2(sp[6 * 33], sp[7 * 33]);
        *(u32x4*)(L.dst + (size_t)(L.row0 + n) * L.ld + L.k0 + 8 * c) = o; }
    LDS_WAIT(); asm volatile("" ::: "memory");
}
__device__ __forceinline__ void wexp_rest(const Ctx& X, const Args& A, int layer, int first, int stride) {
    LAS float* scr = (LAS float*)(X.lds + X.wave * 8704);
    for (int r = first; r < WEXP_ITEMS; r += stride) { float tv[32]; const WexpLoc L = wexp_locate(X, A, layer, r); wexp_issue(L, X.lane, tv); wexp_finish(L, X.lane, tv, scr); }
}

typedef short bf16x8 __attribute__((ext_vector_type(8)));
typedef float f32x16 __attribute__((ext_vector_type(16)));
__device__ __forceinline__ f32x16 mm32(const LAS bf16* A, int lda, const LAS bf16* Bt, int ldb, int ksteps, f32x16 acc, int lane) {
    const LAS bf16* pa = A + (lane & 31) * lda + 8 * (lane >> 5); const LAS bf16* pb = Bt + (lane & 31) * ldb + 8 * (lane >> 5);
    for (int st = 0; st < ksteps; ++st) { const bf16x8 a = *(const LAS bf16x8*)(pa + 16 * st), bq = *(const LAS bf16x8*)(pb + 16 * st); acc = __builtin_amdgcn_mfma_f32_32x32x16_bf16(a, bq, acc, 0, 0, 0); }
    return acc;
}
#define CROW(reg, lane) (((reg) & 3) + 8 * ((reg) >> 2) + 4 * ((lane) >> 5))
__device__ __forceinline__ f32x16 zero16() { f32x16 z;
#pragma unroll
    for (int i = 0; i < 16; ++i) z[i] = 0.f; return z; }
__device__ __forceinline__ void st_rowmajor(const f32x16& c, LAS bf16* dst, int ld, int lane) {
#pragma unroll
    for (int i = 0; i < 16; ++i) dst[CROW(i, lane) * ld + (lane & 31)] = (bf16)f2bf(c[i]);
}
__device__ __forceinline__ void st_transposed(const f32x16& c, LAS bf16* dst, int ld, int lane) {
#pragma unroll
    for (int g = 0; g < 4; ++g) *(LAS u32x2*)(dst + (lane & 31) * ld + 8 * g + 4 * (lane >> 5)) = (u32x2){pk2(c[4 * g], c[4 * g + 1]), pk2(c[4 * g + 2], c[4 * g + 3])};
}
__device__ __forceinline__ f32x16 mm32_regB(const LAS bf16* A, int lda, const f32x16& Xt, f32x16 acc, int lane) {
    const LAS bf16* pa = A + (lane & 31) * lda + 4 * (lane >> 5);
#pragma unroll
    for (int st = 0; st < 2; ++st) {
        const u32x4 bp = (u32x4){pk2(Xt[8 * st], Xt[8 * st + 1]), pk2(Xt[8 * st + 2], Xt[8 * st + 3]), pk2(Xt[8 * st + 4], Xt[8 * st + 5]), pk2(Xt[8 * st + 6], Xt[8 * st + 7])};
        const u32x2 a0 = *(const LAS u32x2*)(pa + 16 * st), a1 = *(const LAS u32x2*)(pa + 16 * st + 8);
        const u32x4 ap = (u32x4){a0.x, a0.y, a1.x, a1.y};
        acc = __builtin_amdgcn_mfma_f32_32x32x16_bf16(__builtin_bit_cast(bf16x8, ap), __builtin_bit_cast(bf16x8, bp), acc, 0, 0, 0); }
    return acc;
}
__device__ __forceinline__ f32x16 mm32_regA(const f32x16& Xt, const LAS bf16* Bt, int ldb, f32x16 acc, int lane) {
    const LAS bf16* pb = Bt + (lane & 31) * ldb + 4 * (lane >> 5);
#pragma unroll
    for (int st = 0; st < 2; ++st) {
        const u32x4 ap = (u32x4){pk2(Xt[8 * st], Xt[8 * st + 1]), pk2(Xt[8 * st + 2], Xt[8 * st + 3]), pk2(Xt[8 * st + 4], Xt[8 * st + 5]), pk2(Xt[8 * st + 6], Xt[8 * st + 7])};
        const u32x2 b0 = *(const LAS u32x2*)(pb + 16 * st), b1 = *(const LAS u32x2*)(pb + 16 * st + 8);
        const u32x4 bp = (u32x4){b0.x, b0.y, b1.x, b1.y};
        acc = __builtin_amdgcn_mfma_f32_32x32x16_bf16(__builtin_bit_cast(bf16x8, ap), __builtin_bit_cast(bf16x8, bp), acc, 0, 0, 0); }
    return acc;
}
#define BLK_BAR() do { asm volatile("s_waitcnt lgkmcnt(0)" ::: "memory"); __builtin_amdgcn_s_barrier(); asm volatile("" ::: "memory"); } while (0)

__device__ __forceinline__ void scan_rwkv(const Ctx& X, const Args& A, int layer, int chain) {
    const int wave = X.wave, tid0 = X.tid;
    const int dir = chain / 48, b = (chain % 48) / 6, h = chain % 6;
    constexpr int LT = 72;
    LAS unsigned char* L0 = X.lds;
    LAS bf16* AR = (LAS bf16*)L0;
    LAS bf16* BK = (LAS bf16*)(L0 + 18432); LAS bf16* R2T = BK;
    LAS bf16* AT = (LAS bf16*)(L0 + 36864); LAS bf16* BT = AT + 64 * LT; LAS bf16* KT2 = BT + 64 * LT; LAS bf16* VT = KT2 + 64 * LT;
    LAS bf16* MAB = (LAS bf16*)(L0 + 73728); LAS bf16* MAK = MAB + 64 * LT; LAS bf16* MRB = MAK + 64 * LT; LAS bf16* MRK = MRB + 64 * LT; LAS bf16* PL = MAB;
    LAS float* DF = (LAS float*)(L0 + 110592);
    LAS bf16* TP0T = (LAS bf16*)(L0 + 118784); LAS bf16* WT = TP0T + 2 * 1280;
    LAS float* LS = (LAS float*)(L0 + 126976); LAS float* WC = (LAS float*)(L0 + 131072);
    LAS bf16* XYT = (LAS bf16*)(L0 + 110592);
    LAS bf16* SBb = (LAS bf16*)(L0 + 131328);
    LAS bf16* TB = (LAS bf16*)(L0 + 149760);
    const bf16* RR = (const bf16*)(X.ws + O_RR); const bf16* RV = (const bf16*)(X.ws + O_RV); const bf16* RKK = (const bf16*)(X.ws + O_RKK);
    const bf16* KTg = (const bf16*)(X.ws + O_KT); const bf16* LO = (const bf16*)(X.ws + O_LO) + dir * 768 + h * 64; float* BS = (float*)(X.ws + O_BS) + (size_t)dir * MT * 6 + h;
    bf16* ORW = (bf16*)(X.ws + O_ORW) + (size_t)dir * MT * RW; const int cm = layer & 1;
    const float* Pw0 = A.in[10] + (size_t)layer * 768 + dir * 384 + h * 64; const float* Pa0 = A.in[12] + (size_t)layer * 768 + dir * 384 + h * 64; const float* Pka = A.in[15] + (size_t)layer * 384 + h * 64; const float* Prk = A.in[16] + (size_t)layer * 384 + h * 64;
    __syncthreads();
    for (int i = X.tid; i < 158976 / 4; i += NTHR) ((LAS unsigned*)L0)[i] = 0u;
    __syncthreads();
    unsigned pr[4], pkk[4], pkt[4], pwp[4], pap[4]; unsigned pv[4];
#define RC_FETCH(ck_) do {   \
        const int q0_ = chain_row(dir, b, (ck_) * 64 + 4 * tg), dq_ = dir ? -1 : 1, dl_ = (cm && (ck_) >= CTXL / 64) ? 64 * dq_ : dq_; \
        const unsigned off0_ = (unsigned)q0_ * (unsigned)RW + (unsigned)(h * 64 + 2 * kp), doff_ = (unsigned)(dq_ * RW); \
        const unsigned lof0_ = (unsigned)scan_row(q0_, cm) * (unsigned)LN + (unsigned)(2 * kp), dlof_ = (unsigned)(dl_ * LN); \
        _Pragma("unroll") for (int i = 0; i < 4; ++i) { const unsigned off_ = off0_ + (unsigned)i * doff_, lof_ = lof0_ + (unsigned)i * dlof_; \
            pr[i] = *(const unsigned*)(RR + off_); pkk[i] = *(const unsigned*)(RKK + off_); pkt[i] = *(const unsigned*)(KTg + off_); pwp[i] = *(const unsigned*)(LO + lof_); pap[i] = *(const unsigned*)(LO + lof_ + 384); \
            pv[i] = *(const unsigned*)(RV + off_); } } while (0)
    { const int kp = tid0 & 31, tg = tid0 >> 5, vq = tid0 & 31, tgv = tid0 >> 5; RC_FETCH(0); }
    for (int ck = 0; ck < (CTXL + SEQ) / 64; ++ck) {
        int td = tid0; asm volatile("" : "+v"(td));
        const int lane = td & 63, kp = td & 31, tg = td >> 5, vq = td & 31, tgv = td >> 5;
        LAS bf16* SBc = SBb + (ck & 1) * 64 * LT; LAS bf16* SBn = SBb + ((ck + 1) & 1) * 64 * LT;
        float c0[4], c1[4], ldx[4], ldy[4], kmx[4], kmy[4], bbx[4], bby[4];
        { const f32x2 w0v = *(const f32x2*)(Pw0 + 2 * kp), a0v = *(const f32x2*)(Pa0 + 2 * kp), kav = *(const f32x2*)(Pka + 2 * kp), rkv = *(const f32x2*)(Prk + 2 * kp);
          float a0 = 0.f, a1 = 0.f; const int bsq0 = chain_row(dir, b, ck * 64 + 4 * tg);
#pragma unroll
          for (int i = 0; i < 4; ++i) {
              ldx[i] = -0.6065306597f * sigmoid_f(w0v.x + bflo(pwp[i])); ldy[i] = -0.6065306597f * sigmoid_f(w0v.y + bfhi(pwp[i]));
              const float av0 = sigmoid_f(a0v.x + bflo(pap[i])), av1 = sigmoid_f(a0v.y + bfhi(pap[i]));
              kmx[i] = bflo(pkt[i]) * (1.f + (av0 - 1.f) * kav.x); kmy[i] = bfhi(pkt[i]) * (1.f + (av1 - 1.f) * kav.y); bbx[i] = bflo(pkk[i]) * av0; bby[i] = bfhi(pkk[i]) * av1;
              { const float bsum = half_sum_fast(bflo(pr[i]) * kmx[i] * rkv.x + bfhi(pr[i]) * kmy[i] * rkv.y);
                  if (kp == 0) BS[(size_t)(bsq0 + (dir ? -i : i)) * 6] = bsum; }
              a0 += ldx[i]; a1 += ldy[i]; c0[i] = a0; c1[i] = a1; }
          *(LAS f32x2*)(LS + tg * 64 + 2 * kp) = (f32x2){a0, a1}; }
        *(LAS u32x2*)(VT + (2 * vq) * LT + 4 * tgv) = (u32x2){(pv[0] & 0xffffu) | (pv[1] << 16), (pv[2] & 0xffffu) | (pv[3] << 16)};
        *(LAS u32x2*)(VT + (2 * vq + 1) * LT + 4 * tgv) = (u32x2){(pv[0] >> 16) | (pv[1] & 0xffff0000u), (pv[2] >> 16) | (pv[3] & 0xffff0000u)};
        BLK_BAR();
        { float o0 = 0.f, o1 = 0.f, t0 = 0.f, t1 = 0.f;
#pragma unroll
          for (int g = 0; g < 16; ++g) { const f32x2 gs = *(const LAS f32x2*)(LS + g * 64 + 2 * kp); o0 += (g < tg) ? gs.x : 0.f; o1 += (g < tg) ? gs.y : 0.f; t0 += gs.x; t1 += gs.y; }
          float ta0[4], ta1[4], tb0[4], tb1[4], tk0[4], tk1[4];
          float pe0 = __expf(o0), pe1 = __expf(o1);
#pragma unroll
          for (int i = 0; i < 4; ++i) { const int t = 4 * tg + i; const float l0 = c0[i] + o0, l1 = c1[i] + o1;
              const float e0 = __expf(l0), e1 = __expf(l1), n0 = __builtin_amdgcn_rcpf(e0), n1 = __builtin_amdgcn_rcpf(e1), p0 = pe0, p1 = pe1; pe0 = e0; pe1 = e1;
              ta0[i] = bflo(pkk[i]) * p0; ta1[i] = bfhi(pkk[i]) * p1; tb0[i] = bbx[i] * n0; tb1[i] = bby[i] * n1; tk0[i] = kmx[i] * n0; tk1[i] = kmy[i] * n1;
              *(LAS unsigned*)(AR + t * LT + 2 * kp) = pk2(ta0[i], ta1[i]); *(LAS unsigned*)(AR + (64 + t) * LT + 2 * kp) = pk2(bflo(pr[i]) * e0, bfhi(pr[i]) * e1);
              *(LAS unsigned*)(BK + t * LT + 2 * kp) = pk2(tb0[i], tb1[i]); *(LAS unsigned*)(BK + (64 + t) * LT + 2 * kp) = pk2(tk0[i], tk1[i]); }
          *(LAS u32x2*)(AT + (2 * kp) * LT + 4 * tg) = (u32x2){pk2(ta0[0], ta0[1]), pk2(ta0[2], ta0[3])}; *(LAS u32x2*)(AT + (2 * kp + 1) * LT + 4 * tg) = (u32x2){pk2(ta1[0], ta1[1]), pk2(ta1[2], ta1[3])};
          *(LAS u32x2*)(BT + (2 * kp) * LT + 4 * tg) = (u32x2){pk2(tb0[0], tb0[1]), pk2(tb0[2], tb0[3])}; *(LAS u32x2*)(BT + (2 * kp + 1) * LT + 4 * tg) = (u32x2){pk2(tb1[0], tb1[1]), pk2(tb1[2], tb1[3])};
          *(LAS u32x2*)(KT2 + (2 * kp) * LT + 4 * tg) = (u32x2){pk2(tk0[0], tk0[1]), pk2(tk0[2], tk0[3])}; *(LAS u32x2*)(KT2 + (2 * kp + 1) * LT + 4 * tg) = (u32x2){pk2(tk1[0], tk1[1]), pk2(tk1[2], tk1[3])};
          if (tg == 0) *(LAS f32x2*)(WC + 2 * kp) = (f32x2){__expf(t0), __expf(t1)}; }
        if (ck + 1 < (CTXL + SEQ) / 64) RC_FETCH(ck + 1);
        BLK_BAR();
        if (wave < 2) { const int p = wave; LAS bf16* TDT = TP0T + p * 1280; LAS bf16* WTp = p ? (LAS bf16*)LS : TP0T + 2560;
            { f32x16 c = mm32(AR + 32 * p * LT, LT, BK + 32 * p * LT, LT, 4, zero16(), lane);
#pragma unroll
              for (int i = 0; i < 16; ++i) if ((lane & 31) >= CROW(i, lane)) c[i] = 0.f;
              st_rowmajor(c, MAB + 32 * p * LT + 32 * p, LT, lane);
#pragma unroll
              for (int i = 0; i < 16; ++i) DF[p * 1024 + CROW(i, lane) * 32 + (lane & 31)] = c[i]; }
            asm volatile("s_waitcnt lgkmcnt(0)" ::: "memory");
            const int bl = (lane >> 4) & 1, cc = lane & 15; const LAS float* Ablk = DF + p * 1024 + (16 * bl) * 32 + 16 * bl;
            float x[16];
#pragma unroll
            for (int i = 0; i < 16; ++i) x[i] = (i == cc) ? 1.f : 0.f;
#pragma unroll
            for (int j = 0; j < 15; ++j) {
#pragma unroll
                for (int i = j + 1; i < 16; ++i) x[i] -= Ablk[i * 32 + j] * x[j]; }
            if (lane < 32) {
#pragma unroll
                for (int i = 0; i < 16; ++i) { TB[(32 * p + 16 * bl + i) * LT + 32 * p + 16 * bl + cc] = (bf16)f2bf(x[i]); TB[(32 * p + 16 * bl + i) * LT + 32 * p + 16 * (1 - bl) + cc] = 0; }
                u32x4 lo, hi; lo.x = pk2(x[0], x[1]); lo.y = pk2(x[2], x[3]); lo.z = pk2(x[4], x[5]); lo.w = pk2(x[6], x[7]); hi.x = pk2(x[8], x[9]); hi.y = pk2(x[10], x[11]); hi.z = pk2(x[12], x[13]); hi.w = pk2(x[14], x[15]);
                LAS bf16* d = TDT + (16 * bl + cc) * 40; *(LAS u32x4*)(d + 16 * bl) = lo; *(LAS u32x4*)(d + 16 * bl + 8) = hi;
                const u32x4 z = (u32x4){0u, 0u, 0u, 0u}; *(LAS u32x4*)(d + 16 * (1 - bl)) = z; *(LAS u32x4*)(d + 16 * (1 - bl) + 8) = z; }
            asm volatile("s_waitcnt lgkmcnt(0)" ::: "memory");
            const f32x16 w2 = mm32(MAB + 32 * p * LT + 32 * p, LT, TDT, 40, 2, zero16(), lane); st_transposed(w2, WTp, 40, lane);
            asm volatile("s_waitcnt lgkmcnt(0)" ::: "memory");
            const f32x16 c2 = mm32(TB + 32 * p * LT + 32 * p, LT, WTp, 40, 2, zero16(), lane);
            if ((lane & 31) < 16) {
#pragma unroll
                for (int i = 8; i < 16; ++i) TB[(32 * p + CROW(i, lane)) * LT + 32 * p + (lane & 31)] = (bf16)f2bf(-c2[i]);
                if (p == 0) { LAS bf16* d = TDT + (lane & 31) * 40 + 16 + 4 * (lane >> 5);
                    *(LAS u32x2*)(d) = (u32x2){pk2(-c2[8], -c2[9]), pk2(-c2[10], -c2[11])}; *(LAS u32x2*)(d + 8) = (u32x2){pk2(-c2[12], -c2[13]), pk2(-c2[14], -c2[15])}; } }
        } else if (wave < 7) {
#pragma unroll
            for (int s2 = 0; s2 < 2; ++s2) { const int tl = (wave - 2) * 2 + s2;
                const int qd = tl == 0 ? 0 : tl < 4 ? 1 : tl < 7 ? 2 : 3;
                const int ti = (tl == 1 || tl == 4 || tl == 8) ? 0 : 1, tj = (tl == 3 || tl == 5 || tl == 9) ? 1 : 0;
                f32x16 c = mm32(AR + ((qd >> 1) * 64 + 32 * ti) * LT, LT, BK + ((qd & 1) * 64 + 32 * tj) * LT, LT, 4, zero16(), lane);
                if (ti == tj) { const int strict = (qd < 2) ? 1 : 0;
#pragma unroll
                    for (int i = 0; i < 16; ++i) if ((lane & 31) + strict > CROW(i, lane)) c[i] = 0.f; }
                st_rowmajor(c, MAB + qd * 64 * LT + 32 * ti * LT + 32 * tj, LT, lane); }
        } else {
#pragma unroll
            for (int e = 0; e < 16; ++e) { const int idx = lane * 16 + e; TB[(idx >> 5) * LT + 32 + (idx & 31)] = 0; } }
        BLK_BAR();
        f32x16 qt = zero16();
        f32x16 ntp = zero16();
        if (wave == 0) { const f32x16 w3 = mm32(MAB + 32 * LT, LT, TP0T, 40, 2, zero16(), lane); st_transposed(w3, WT, 40, lane);
            asm volatile("s_waitcnt lgkmcnt(0)" ::: "memory");
            f32x16 tl = mm32(WT, 40, TB + 32 * LT + 32, LT, 2, zero16(), lane);
#pragma unroll
            for (int i = 0; i < 16; ++i) tl[i] = -tl[i];
            st_transposed(tl, TB + 32 * LT, LT, lane);
        } else if (wave >= 4) { const int ti = wave & 1, vh = (wave - 4) >> 1;
            const f32x16 c = mm32(MAK + 32 * ti * LT, LT, VT + 32 * vh * LT, LT, ti ? 4 : 2, zero16(), lane); st_transposed(c, R2T + 32 * vh * LT + 32 * ti, LT, lane);
            qt = mm32(VT + 32 * vh * LT, LT, MRK + 32 * ti * LT, LT, ti ? 4 : 2, zero16(), lane);
        } else { const int kj = wave & 1, vh = wave >> 1;
            ntp = mm32(KT2 + 32 * kj * LT, LT, VT + 32 * vh * LT, LT, 4, zero16(), lane); }
        BLK_BAR();
        if (wave < 4) { const int ti = wave >> 1, kj = wave & 1;
            const f32x16 x0 = mm32(TB, LT, AT + 32 * kj * LT, LT, 2, zero16(), lane);
            f32x16 c = mm32_regA(x0, MRB + 32 * ti * LT, LT, zero16(), lane);
            if (ti) { const f32x16 x1 = mm32(TB + 32 * LT, LT, AT + 32 * kj * LT, LT, 4, zero16(), lane);
                c = mm32_regA(x1, MRB + 32 * LT + 32, LT, c, lane);
                st_transposed(x0, XYT + 32 * kj * LT, LT, lane); st_transposed(x1, XYT + 32 * kj * LT + 32, LT, lane); }
#pragma unroll
            for (int g4 = 0; g4 < 4; ++g4) { const u32x2 rv = *(const LAS u32x2*)(AR + (64 + 32 * ti + (lane & 31)) * LT + 32 * kj + 8 * g4 + 4 * (lane >> 5));
                c[4 * g4] = bflo(rv.x) - c[4 * g4]; c[4 * g4 + 1] = bfhi(rv.x) - c[4 * g4 + 1]; c[4 * g4 + 2] = bflo(rv.y) - c[4 * g4 + 2]; c[4 * g4 + 3] = bfhi(rv.y) - c[4 * g4 + 3]; }
            st_transposed(c, PL + 32 * ti * LT + 32 * kj, LT, lane);
            if (wave == 0) ntp = mm32(KT2, LT, VT, LT, 4, zero16(), lane);
        } else { const int ti = wave & 1, vh = (wave - 4) >> 1;
            const f32x16 y0 = mm32(TB, LT, R2T + 32 * vh * LT, LT, 2, zero16(), lane);
            f32x16 qn = mm32_regA(y0, MRB + 32 * ti * LT, LT, zero16(), lane);
            if (ti) { const f32x16 y1 = mm32(TB + 32 * LT, LT, R2T + 32 * vh * LT, LT, 4, zero16(), lane);
                qn = mm32_regA(y1, MRB + 32 * LT + 32, LT, qn, lane);
                st_transposed(y0, XYT + (64 + 32 * vh) * LT, LT, lane); st_transposed(y1, XYT + (64 + 32 * vh) * LT + 32, LT, lane); }
#pragma unroll
            for (int i = 0; i < 16; ++i) qt[i] -= qn[i]; }
        BLK_BAR();
        if (wave >= 4) { const int ti = wave & 1, vh = (wave - 4) >> 1;
            const f32x16 o = mm32(SBc + 32 * vh * LT, LT, PL + 32 * ti * LT, LT, 4, qt, lane);
            bf16* orow = ORW + ((unsigned)chain_row(dir, b, ck * 64 + 32 * ti + (lane & 31)) * (unsigned)RW + (unsigned)(h * 64 + 32 * vh + 4 * (lane >> 5)));
#pragma unroll
            for (int g4 = 0; g4 < 4; ++g4) *(u32x2*)(orow + 8 * g4) = (u32x2){pk2(o[4 * g4], o[4 * g4 + 1]), pk2(o[4 * g4 + 2], o[4 * g4 + 3])};
        } else { const int kj = wave & 1, vh = wave >> 1; const float wc = WC[32 * kj + (lane & 31)];
            f32x16 nt = ntp;
            const f32x16 nn = mm32(BT + 32 * kj * LT, LT, XYT + (64 + 32 * vh) * LT, LT, 4, zero16(), lane);
#pragma unroll
            for (int g4 = 0; g4 < 4; ++g4) { const f32x4 w4 = *(const LAS f32x4*)(WC + 32 * kj + 8 * g4 + 4 * (lane >> 5));
#pragma unroll
                for (int r = 0; r < 4; ++r) nt[4 * g4 + r] = (nt[4 * g4 + r] - nn[4 * g4 + r]) * w4[r]; }
#pragma unroll
            for (int ki = 0; ki < 2; ++ki) { f32x16 g = mm32(XYT + 32 * ki * LT, LT, BT + 32 * kj * LT, LT, 4, zero16(), lane);
#pragma unroll
                for (int i = 0; i < 16; ++i) g[i] = (((32 * ki + CROW(i, lane)) == (32 * kj + (lane & 31)) ? 1.f : 0.f) - g[i]) * wc;
                nt = mm32_regA(g, SBc + 32 * vh * LT + 32 * ki, LT, nt, lane); }
            st_transposed(nt, SBn + 32 * vh * LT + 32 * kj, LT, lane); }
        BLK_BAR();
    }
#undef RC_FETCH
    __syncthreads();
}
__device__ __forceinline__ void scan_gla(const Ctx& X, const Args& A, int layer, int chain) {
    const int dir = chain / 32, b = (chain % 32) / 4, h = chain % 4, lane = X.lane, wave = X.wave;
    constexpr int LQ = 56, LT = 72;
    LAS bf16* QI = (LAS bf16*)X.lds; LAS bf16* KI = QI + 64 * LQ; LAS bf16* KTt = KI + 64 * LQ; LAS bf16* VT = KTt + 64 * LT; LAS bf16* ATT = VT + 96 * LT; LAS bf16* ST = ATT + 64 * LT;
    LAS float* gsum = (LAS float*)(ST + 96 * LQ); LAS float* dec = gsum + 16 * 48;
    const bf16* GQ = (const bf16*)(X.ws + O_GQ); const bf16* GK = (const bf16*)(X.ws + O_GK); const bf16* GV = (const bf16*)(X.ws + O_GV);
    const bf16* LOg = (const bf16*)(X.ws + O_LO) + 1536 + dir * 192 + h * 48; const float* Pab = A.in[21] + (size_t)layer * 384 + dir * 192 + h * 48; const int cm = layer & 1;
    bf16* OGL = (bf16*)(X.ws + O_OGL) + (size_t)dir * MT * GVW;
    __syncthreads();
    for (int i = X.tid; i < (64 * LQ * 2 + 64 * LT + 96 * LT + 64 * LT + 96 * LQ) / 2; i += NTHR) ((LAS unsigned*)QI)[i] = 0u;
    if (X.tid < 64) dec[X.tid] = 0.f;
    __syncthreads();
    const int kp = X.tid & 31, tg = X.tid >> 5;
    const int vp = X.tid & 63, tg8 = X.tid >> 6;
    unsigned pq[4], pk[4], pg[4]; unsigned pv[8];
#define GC_FETCH(ck_) do { \
        if (kp < 24) { _Pragma("unroll") for (int i = 0; i < 4; ++i) { const int q_ = chain_row(dir, b, (ck_) * 64 + 4 * tg + i); const unsigned off_ = (unsigned)q_ * (unsigned)GKW + (unsigned)(h * 48 + 2 * kp); \
            pq[i] = *(const unsigned*)(GQ + off_); pk[i] = *(const unsigned*)(GK + off_); pg[i] = *(const unsigned*)(LOg + ((unsigned)scan_row(q_, cm) * (unsigned)LN + (unsigned)(2 * kp))); } } \
        if (vp < 48) { _Pragma("unroll") for (int i = 0; i < 8; ++i) pv[i] = *(const unsigned*)(GV + ((unsigned)chain_row(dir, b, (ck_) * 64 + 8 * tg8 + i) * (unsigned)GVW + (unsigned)(h * 96 + 2 * vp))); } } while (0)
    GC_FETCH(0);
    f32x16 S = zero16();
    const int smi = wave / 3, sni = wave % 3;
    for (int ck = 0; ck < (CTXL + SEQ) / 64; ++ck) {
        float g0[4], g1[4];
        if (kp < 24) { float a0 = 0.f, a1 = 0.f; const f32x2 abv = *(const f32x2*)(Pab + 2 * kp);
#pragma unroll
            for (int i = 0; i < 4; ++i) { a0 += logsigmoid_f(bflo(pg[i]) + abv.x) * (1.f / 16.f); a1 += logsigmoid_f(bfhi(pg[i]) + abv.y) * (1.f / 16.f); g0[i] = a0; g1[i] = a1; }
            *(LAS f32x2*)(gsum + tg * 48 + 2 * kp) = (f32x2){a0, a1}; }
        if (vp < 48) {
            u32x4 lo, hi;
            lo.x = (pv[0] & 0xffffu) | (pv[1] << 16); lo.y = (pv[2] & 0xffffu) | (pv[3] << 16); lo.z = (pv[4] & 0xffffu) | (pv[5] << 16); lo.w = (pv[6] & 0xffffu) | (pv[7] << 16);
            hi.x = (pv[0] >> 16) | (pv[1] & 0xffff0000u); hi.y = (pv[2] >> 16) | (pv[3] & 0xffff0000u); hi.z = (pv[4] >> 16) | (pv[5] & 0xffff0000u); hi.w = (pv[6] >> 16) | (pv[7] & 0xffff0000u);
            *(LAS u32x4*)(VT + (2 * vp) * LT + 8 * tg8) = lo; *(LAS u32x4*)(VT + (2 * vp + 1) * LT + 8 * tg8) = hi; }
        BLK_BAR();
        if (kp < 24) { float o0 = 0.f, o1 = 0.f, t0 = 0.f, t1 = 0.f;
#pragma unroll
            for (int g = 0; g < 16; ++g) { const f32x2 gs = *(const LAS f32x2*)(gsum + g * 48 + 2 * kp); o0 += (g < tg) ? gs.x : 0.f; o1 += (g < tg) ? gs.y : 0.f; t0 += gs.x; t1 += gs.y; }
            unsigned kt0[4], kt1[4]; const float et0 = __expf(t0), et1 = __expf(t1);
#pragma unroll
            for (int i = 0; i < 4; ++i) { const float c0 = g0[i] + o0, c1 = g1[i] + o1; const int t = 4 * tg + i;
                const float e0 = __expf(c0), e1 = __expf(c1), n0 = __builtin_amdgcn_rcpf(e0), n1 = __builtin_amdgcn_rcpf(e1), l0 = et0 * n0, l1 = et1 * n1;
                const float q0 = bflo(pq[i]), q1 = bfhi(pq[i]), k0 = bflo(pk[i]), k1 = bfhi(pk[i]);
                *(LAS unsigned*)(QI + t * LQ + 2 * kp) = pk2(q0 * e0, q1 * e1); *(LAS unsigned*)(KI + t * LQ + 2 * kp) = pk2(k0 * n0, k1 * n1);
                kt0[i] = f2bf(k0 * l0); kt1[i] = f2bf(k1 * l1); }
            *(LAS u32x2*)(KTt + (2 * kp) * LT + 4 * tg) = (u32x2){kt0[0] | (kt0[1] << 16), kt0[2] | (kt0[3] << 16)};
            *(LAS u32x2*)(KTt + (2 * kp + 1) * LT + 4 * tg) = (u32x2){kt1[0] | (kt1[1] << 16), kt1[2] | (kt1[3] << 16)};
            if (tg == 0) *(LAS f32x2*)(dec + 2 * kp) = (f32x2){et0, et1}; }
        if (ck + 1 < (CTXL + SEQ) / 64) GC_FETCH(ck + 1);
        BLK_BAR();
        f32x16 kv = zero16();
        if (wave < 6) kv = mm32(KTt + 32 * smi * LT, LT, VT + 32 * sni * LT, LT, 4, kv, lane);
        else if (wave == 6) {
#pragma unroll
            for (int d = 0; d < 2; ++d) { f32x16 c = mm32(QI + 32 * d * LQ, LQ, KI + 32 * d * LQ, LQ, 3, zero16(), lane);
#pragma unroll
                for (int i = 0; i < 16; ++i) if ((lane & 31) > CROW(i, lane)) c[i] = 0.f;
                st_rowmajor(c, ATT + 32 * d * LT + 32 * d, LT, lane); }
        } else { const f32x16 c = mm32(QI + 32 * LQ, LQ, KI, LQ, 3, zero16(), lane); st_rowmajor(c, ATT + 32 * LT, LT, lane); }
        BLK_BAR();
        if (wave < 6) { f32x16 o = mm32(ATT + 32 * smi * LT, LT, VT + 32 * sni * LT, LT, smi ? 4 : 2, zero16(), lane);
            o = mm32(QI + 32 * smi * LQ, LQ, ST + 32 * sni * LQ, LQ, 3, o, lane);
#pragma unroll
            for (int i = 0; i < 16; ++i) OGL[(unsigned)chain_row(dir, b, ck * 64 + 32 * smi + CROW(i, lane)) * (unsigned)GVW + (unsigned)(h * 96 + 32 * sni + (lane & 31))] = (bf16)f2bf(o[i]); }
        BLK_BAR();
        if (wave < 6) {
#pragma unroll
            for (int i = 0; i < 16; ++i) S[i] = S[i] * dec[32 * smi + CROW(i, lane)] + kv[i];
            if (smi == 0) st_transposed(S, ST + 32 * sni * LQ, LQ, lane);
            else {
#pragma unroll
                for (int g = 0; g < 2; ++g) *(LAS u32x2*)(ST + (32 * sni + (lane & 31)) * LQ + 32 + 8 * g + 4 * (lane >> 5)) = (u32x2){pk2(S[4 * g], S[4 * g + 1]), pk2(S[4 * g + 2], S[4 * g + 3])}; }
        }
        BLK_BAR();
    }
#undef GC_FETCH
    __syncthreads();
}
__device__ __forceinline__ void phase_scan(const Ctx& X, const Args& A, int layer) {
    for (int it = X.bid; it < 96 + 64; it += X.nb) {
        if (it < 96) scan_rwkv(X, A, layer, it);
        else scan_gla(X, A, layer, it - 96);
    }
    { const bool spare = (X.nb == 256); const int dg = spare ? 96 : X.nb, dc = spare ? X.bid - 160 : X.bid;
      if (dc >= 0) { pg8::Gemm g{(const bf16*)(X.ws + O_ADFT), (const bf16*)(X.ws + O_FCT), 2 * SEQ, 2048, SEQ, SEQ, SEQ}; pg8::GroupOrder S; S.init(2, 16, 8, dg, dc, 16, 1);
          EpiDft E{(bf16*)(X.ws + O_FO), 0};
          __syncthreads();
          pg8::gemm_phase<EpiDft, pg8::GroupOrder>((LAS unsigned char*)X.lds, g, S, E, X.tid);
          __syncthreads();
          { pg8::Gemm g2{(const bf16*)(X.ws + O_ADFTC), (const bf16*)(X.ws + O_FCTC), 2 * CTXL, 2048, CTXL, CTXL, CTXL}; pg8::StaticOrder S2; S2.init(2 * CTXL, 2048, dg, dc);
            EpiDft E2{(bf16*)(X.ws + O_FO), 1};
            pg8::gemm_phase<EpiDft, pg8::StaticOrder>((LAS unsigned char*)X.lds, g2, S2, E2, X.tid);
            __syncthreads(); } } }
    { unsigned* qhead = (unsigned*)(X.ws + O_CTL) + 8192 + 64 * layer;
      LAS float* scr = (LAS float*)(X.lds + X.wave * 8704);
      for (;;) { unsigned r0 = 0; if (X.lane == 0) r0 = __hip_atomic_fetch_add(qhead, 16u, __ATOMIC_RELAXED, __HIP_MEMORY_SCOPE_AGENT);
          r0 = __builtin_amdgcn_readfirstlane(r0); if (r0 >= (unsigned)WEXP_ITEMS) break;
          float ta[32], tb[32]; WexpLoc La = wexp_locate(X, A, layer, (int)r0), Lb = La; wexp_issue(La, X.lane, ta);
#pragma unroll 1
          for (unsigned r = r0; r < r0 + 16u; r += 2) {
              Lb = wexp_locate(X, A, layer, (int)r + 1); wexp_issue(Lb, X.lane, tb);
              wexp_finish(La, X.lane, ta, scr);
              if (r + 2 < r0 + 16u) { La = wexp_locate(X, A, layer, (int)r + 2); wexp_issue(La, X.lane, ta); }
              wexp_finish(Lb, X.lane, tb, scr); } } }
}

constexpr float YSC = 1.f / 255.f;
struct PostRaw { u32x4 of, ob, bw, gw4; float bs0, bs1; unsigned ga[3], gb[3], og[3]; unsigned short fa[4], fb[4]; };
__device__ __forceinline__ void post_load(PostRaw& R, const unsigned char* ws, const int r, const int cm, const int lane) {
    const bf16* ORW = (const bf16*)(ws + O_ORW); const bf16* OGL = (const bf16*)(ws + O_OGL); const bf16* RVp = (const bf16*)(ws + O_RV); const float* BSp = (const float*)(ws + O_BS);
    const bf16* LO = (const bf16*)(ws + O_LO); const bf16* Z = (const bf16*)(ws + O_Z); const bf16* FO = (const bf16*)(ws + O_FO);
    const int q = scan_row(r, cm);
    const int c1 = 8 * lane;
    if (lane < 48) { R.of = *(const u32x4*)(ORW + (size_t)q * RW + c1); R.ob = *(const u32x4*)(ORW + ((size_t)MT + q) * RW + c1); R.bw = *(const u32x4*)(RVp + (size_t)q * RW + c1); R.gw4 = *(const u32x4*)(LO + (size_t)r * LN + 1920 + c1);
        R.bs0 = BSp[(size_t)q * 6 + (lane >> 3)]; R.bs1 = BSp[((size_t)MT + q) * 6 + (lane >> 3)]; }
    const int c2 = (lane >> 4) * 96 + (lane & 15) * 6;
#pragma unroll
    for (int i = 0; i < 3; ++i) { R.ga[i] = *(const unsigned*)(OGL + (size_t)q * GVW + c2 + 2 * i); R.gb[i] = *(const unsigned*)(OGL + ((size_t)MT + q) * GVW + c2 + 2 * i); R.og[i] = *(const unsigned*)(Z + (size_t)r * NZ + ZC_OG + c2 + 2 * i); }
    { const bf16* f0 = FO + (size_t)r * 256 + (lane >> 4) * 64; const bf16* f1 = f0 + (size_t)MT * 256;
#pragma unroll
      for (int e = 0; e < 4; ++e) { const int cp = (4 * lane + e) & 63, cf = cp <= 32 ? cp : 64 - cp; R.fa[e] = f0[cf]; R.fb[e] = f1[(cp == 0 || cp == 32) ? cf : 32 + cf]; } }
}
__device__ __forceinline__ void phase_post(const Ctx& X, const Args& A, int layer, int rows) {
    const int cm = layer & 1, lane = X.lane;
    const int gw = X.bid * NWAVE + X.wave, NGW = X.nb * NWAVE;
    bf16* Y = (bf16*)(X.ws + O_Y);
    const float* lnw = A.in[18] + (size_t)layer * RW; const float* lnb = A.in[19] + (size_t)layer * RW; const float* gnw = A.in[22] + (size_t)layer * 96;
    const bool p1 = lane < 48; const int c1 = 8 * lane, c2 = (lane >> 4) * 96 + (lane & 15) * 6;
    f32x4 w0 = (f32x4){0.f, 0.f, 0.f, 0.f}, w1 = w0, b0 = w0, b1 = w0; f32x2 gwt[3];
    if (p1) { w0 = *(const f32x4*)(lnw + c1); w1 = *(const f32x4*)(lnw + c1 + 4); b0 = *(const f32x4*)(lnb + c1); b1 = *(const f32x4*)(lnb + c1 + 4); }
#pragma unroll
    for (int i = 0; i < 3; ++i) gwt[i] = *(const f32x2*)(gnw + (lane & 15) * 6 + 2 * i);
    PostRaw R; R.of = R.ob = R.bw = R.gw4 = (u32x4){0u, 0u, 0u, 0u}; R.bs0 = R.bs1 = 0.f;
#pragma unroll
    for (int e = 0; e < 4; ++e) { R.fa[e] = 0; R.fb[e] = 0; }
    if (gw < rows) post_load(R, X.ws, gw, cm, lane);
    for (int r = gw; r < rows; r += NGW) {
        const PostRaw C = R;
        if (r + NGW < rows) post_load(R, X.ws, r + NGW, cm, lane);
        if (p1) {
            const float bsc = C.bs0 + C.bs1;
            float o[8]; float sm = 0.f;
#pragma unroll
            for (int e = 0; e < 4; ++e) { o[2 * e] = bflo(C.of[e]) + bflo(C.ob[e]); o[2 * e + 1] = bfhi(C.of[e]) + bfhi(C.ob[e]); sm += o[2 * e] + o[2 * e + 1]; }
            const float mu = sum8(sm) * (1.f / 64.f); float sq = 0.f;
#pragma unroll
            for (int e = 0; e < 8; ++e) { o[e] -= mu; sq += o[e] * o[e]; }
            const float rs = __builtin_amdgcn_rsqf(sum8(sq) * (1.f / 64.f) + RW_GN_EPS);
            float y[8];
#pragma unroll
            for (int e = 0; e < 8; ++e) { const float bo = bsc * ((e & 1) ? bfhi(C.bw[e >> 1]) : bflo(C.bw[e >> 1])), gg = (e & 1) ? bfhi(C.gw4[e >> 1]) : bflo(C.gw4[e >> 1]);
                y[e] = (o[e] * rs * (e < 4 ? w0[e] : w1[e - 4]) + (e < 4 ? b0[e] : b1[e - 4]) + bo) * gg; }
            *(u32x4*)(Y + (size_t)r * D + c1) = (u32x4){pk2(y[0] * YSC, y[1] * YSC), pk2(y[2] * YSC, y[3] * YSC), pk2(y[4] * YSC, y[5] * YSC), pk2(y[6] * YSC, y[7] * YSC)}; }
        { float o[6];
#pragma unroll
          for (int i = 0; i < 3; ++i) { o[2 * i] = bflo(C.ga[i]) + bflo(C.gb[i]); o[2 * i + 1] = bfhi(C.ga[i]) + bfhi(C.gb[i]); }
          float ss = 0.f;
#pragma unroll
          for (int i = 0; i < 6; ++i) ss += o[i] * o[i];
          ss = sum16(ss);
          const float rs = __builtin_amdgcn_rsqf(ss * (1.f / 96.f) + NORM_EPS);
#pragma unroll
          for (int i = 0; i < 3; ++i)
              *(unsigned*)(Y + (size_t)r * D + 384 + c2 + 2 * i) = pk2(o[2 * i] * (rs * YSC) * gwt[i].x * silu_f(bflo(C.og[i])), o[2 * i + 1] * (rs * YSC) * gwt[i].y * silu_f(bfhi(C.og[i]))); }
        { f32x4 v;
#pragma unroll
          for (int e = 0; e < 4; ++e) { const int cp = (4 * lane + e) & 63; const float sg = (cp == 0 || cp == 32) ? 0.f : (cp < 32 ? 1.f : -1.f);
              v[e] = bf1(C.fa[e]) + sg * bf1(C.fb[e]); }
          *(u32x2*)(Y + (size_t)r * D + 768 + 4 * lane) = (u32x2){pk2(v.x * YSC, v.y * YSC), pk2(v.z * YSC, v.w * YSC)}; }
    }
}

__device__ __forceinline__ void phase_norm2(const Ctx& X, const Args& A, int layer, int rows) {
    LAS float* rt = (LAS float*)X.lds;
    { const float* rw = A.in[27] + (size_t)layer * D * NE;
      float rv[D * NE / NTHR];
#pragma unroll
      for (int k = 0; k < D * NE / NTHR; ++k) rv[k] = rw[X.tid + NTHR * k];
#pragma unroll
      for (int k = 0; k < D * NE / NTHR; ++k) { const int i = X.tid + NTHR * k, c = i >> 4, e = i & 15; rt[(c >> 2) * 68 + 4 * e + (c & 3)] = rv[k]; } }
    __syncthreads();
    const int gw = X.bid * NWAVE + X.wave, NGW = X.nb * NWAVE, lane = X.lane;
    const bf16* H = (const bf16*)(X.ws + O_H); bf16* U = (bf16*)(X.ws + O_U); const float* MOD = (const float*)(X.ws + O_MOD);
    float* AFFL = (float*)(X.ws + O_AFFL); float* AFFC = (float*)(X.ws + O_AFFC);
    const float* nw = A.in[7] + (size_t)layer * D;
    const int npair = rows >> 1;
    u32x2 hw[2][4];
    { const bf16* hr = H + (size_t)(gw < npair ? 2 * gw : 0) * D + 4 * lane;
#pragma unroll
      for (int q = 0; q < 2; ++q)
#pragma unroll
          for (int j = 0; j < 4; ++j) hw[q][j] = *(const u32x2*)(hr + q * D + 256 * j); }
    for (int p = gw; p < npair; p += NGW) {
        const int r0 = 2 * p, mi = mod_index(r0);
        f32x4 h[2][4]; float ss[2] = {0.f, 0.f};
#pragma unroll
        for (int q = 0; q < 2; ++q)
#pragma unroll
            for (int j = 0; j < 4; ++j) { const u32x2 w = hw[q][j]; h[q][j] = (f32x4){bflo(w.x), bfhi(w.x), bflo(w.y), bfhi(w.y)}; ss[q] += (h[q][j].x * h[q][j].x + h[q][j].y * h[q][j].y) + (h[q][j].z * h[q][j].z + h[q][j].w * h[q][j].w); }
        const float* md = MOD + ((size_t)layer * 9 + mi) * 6144 + 3072 + 4 * lane;
        f32x4 sh[4], sc[4], nwv[4];
#pragma unroll
        for (int j = 0; j < 4; ++j) { sh[j] = *(const f32x4*)(md + 256 * j); sc[j] = *(const f32x4*)(md + 1024 + 256 * j); nwv[j] = *(const f32x4*)(nw + 4 * lane + 256 * j); }
        { const int pn = p + NGW < npair ? p + NGW : p; const bf16* hn = H + (size_t)(2 * pn) * D + 4 * lane;
#pragma unroll
          for (int q = 0; q < 2; ++q)
#pragma unroll
              for (int j = 0; j < 4; ++j) hw[q][j] = *(const u32x2*)(hn + q * D + 256 * j); }
        f32x2 hp[4][4], lg2[16];
#pragma unroll
        for (int q = 0; q < 2; ++q) { const float rs = __builtin_amdgcn_rsqf(wave_sum_fast(ss[q]) * (1.f / D) + NORM_EPS);
            bf16* ur = U + (size_t)(r0 + q) * D + 4 * lane;
#pragma unroll
            for (int j = 0; j < 4; ++j) { h[q][j] = h[q][j] * rs * nwv[j] * (sc[j] + 1.f) + sh[j]; *(u32x2*)(ur + 256 * j) = (u32x2){pk2(h[q][j].x, h[q][j].y), pk2(h[q][j].z, h[q][j].w)}; } }
#pragma unroll
        for (int j = 0; j < 4; ++j)
#pragma unroll
            for (int c = 0; c < 4; ++c) hp[j][c] = (f32x2){h[0][j][c], h[1][j][c]};
#pragma unroll
        for (int e = 0; e < 16; ++e) lg2[e] = (f32x2){0.f, 0.f};
#pragma unroll
        for (int j = 0; j < 4; ++j) { asm volatile("" ::: "memory");
            const LAS float* rr = rt + (lane + 64 * j) * 68;
#pragma unroll
            for (int e = 0; e < 16; ++e) { const f32x4 wv = *(const LAS f32x4*)(rr + 4 * e);
                lg2[e] += hp[j][0] * (f32x2){wv.x, wv.x}; lg2[e] += hp[j][1] * (f32x2){wv.y, wv.y}; lg2[e] += hp[j][2] * (f32x2){wv.z, wv.z}; lg2[e] += hp[j][3] * (f32x2){wv.w, wv.w}; } }
#pragma unroll
        for (int q = 0; q < 2; ++q) { const int r = r0 + q;
            float lg[16];
#pragma unroll
            for (int e = 0; e < 16; ++e) lg[e] = q ? lg2[e].y : lg2[e].x;
            float v8[8], v4[4], v2[2], lv;
#pragma unroll
            for (int i = 0; i < 8; ++i) v8[i] = swap32_add(lg[i], lg[i + 8]);
#pragma unroll
            for (int i = 0; i < 4; ++i) v4[i] = swap16_add(v8[i], v8[i + 4]);
            { const bool hi = (lane & 8) != 0;
#pragma unroll
              for (int i = 0; i < 2; ++i) v2[i] = (hi ? v4[i + 2] : v4[i]) + dpp_mov<0x128>(hi ? v4[i] : v4[i + 2]); }
            { const bool hi = (lane & 4) != 0; lv = (hi ? v2[1] : v2[0]) + dpp_mov<0x141>(hi ? v2[0] : v2[1]); }
            lv = sum4(lv);
            float mx = lv;
            mx = swap32_max(mx); mx = swap16_max(mx); mx = fmaxf(mx, dpp_mov<0x128>(mx)); mx = fmaxf(mx, dpp_mov<0x141>(mx));
            const float ex = __expf(lv - mx);
            float den = swap32_add(ex, ex); den = swap16_add(den, den); den += dpp_mov<0x128>(den); den += dpp_mov<0x141>(den);
            const float mine = ex * __builtin_amdgcn_rcpf(den); const int e = ((lane >> 5) & 1) * 8 + ((lane >> 4) & 1) * 4 + ((lane >> 3) & 1) * 2 + ((lane >> 2) & 1);
            if ((lane & 3) == 0) { if (r < ML) AFFL[((size_t)(r >> 12) * NE + e) * SEQ + (r & 4095)] = mine; else { const int rc = r - ML; AFFC[((size_t)(rc >> 8) * NE + e) * CTXL + (rc & 255)] = mine; } } }
    }
}

__device__ __forceinline__ int block_sum_i(const Ctx& X, LAS int* red, int v, int& par) {
    int wt = 0;
#pragma unroll
    for (int bt = 0; bt < 4; ++bt) wt += __popcll(__ballot((v >> bt) & 1)) << bt;
    LAS int* r = red + 16 * (par & 1); ++par;
    if (X.lane == 0) r[X.wave] = wt;
    __syncthreads();
    int t = 0;
#pragma unroll
    for (int w = 0; w < NWAVE; ++w) t += r[w];
    return t;
}
__device__ __forceinline__ void block_scan_flag(const Ctx& X, LAS int* red, bool f, int& excl, int& total, int& par) {
    const unsigned long long m = __ballot(f);
    const int before = __popcll(m & ((1ull << X.lane) - 1ull)), wt = __popcll(m);
    LAS int* r = red + 16 * (par & 1); ++par;
    if (X.lane == 0) r[X.wave] = wt;
    __syncthreads();
    int off = 0, t = 0;
#pragma unroll
    for (int w = 0; w < NWAVE; ++w) { const int x = r[w]; off += (w < X.wave) ? x : 0; t += x; }
    excl = off + before; total = t;
}
__device__ __forceinline__ void phase_topk(const Ctx& X, bool last) {
    LAS int* red = (LAS int*)X.lds; int par = 0;
    const float* AFFL = (const float*)(X.ws + O_AFFL); const float* AFFC = (const float*)(X.ws + O_AFFC);
    int* TOK = (int*)(X.ws + O_TOK); float* GATE = (float*)(X.ws + O_GATE); int* SEL = (int*)(X.ws + O_SEL);
    for (int it = X.bid; it < (last ? 128 : 256); it += X.nb) {
        const bool lat = it < 128; const int id = it & 127, b = id >> 4, e = id & 15;
        const int T = lat ? SEQ : CTXL, cap = lat ? CAPL : CAPC;
        const float* src = lat ? AFFL + ((size_t)b * NE + e) * SEQ : AFFC + ((size_t)b * NE + e) * CTXL;
        const int tokbase = lat ? b * SEQ : ML + b * CTXL, slotbase = e * ME + (lat ? b * CAPL : NB * CAPL + b * CAPC);
        unsigned x[8];
#pragma unroll
        for (int j = 0; j < 8; ++j) { const int t = X.tid + NTHR * j; x[j] = t < T ? __float_as_uint(src[t]) : 0u; }
        unsigned thr = 0u;
        for (int bit = 30; bit >= 0; --bit) { const unsigned cand = thr | (1u << bit); int cnt = 0;
#pragma unroll
            for (int j = 0; j < 8; ++j) cnt += (x[j] >= cand) ? 1 : 0;
            if (block_sum_i(X, red, cnt, par) >= cap) thr = cand; }
        int ngt = 0;
#pragma unroll
        for (int j = 0; j < 8; ++j) ngt += (x[j] > thr) ? 1 : 0;
        const int need = cap - block_sum_i(X, red, ngt, par);
        int run_sel = 0, run_eq = 0;
#pragma unroll
        for (int j = 0; j < 8; ++j) { const int t = X.tid + NTHR * j;
            if (j * NTHR < T) {
                const bool g = x[j] > thr, eq = (x[j] == thr) && (t < T);
                int ex, tot; block_scan_flag(X, red, eq, ex, tot, par);
                const bool sel = g || (eq && (run_eq + ex) < need);
                run_eq += tot;
                int ex2, tot2; block_scan_flag(X, red, sel, ex2, tot2, par);
                if (t < T) { const int slot = slotbase + run_sel + ex2;
                    if (sel) { TOK[slot] = tokbase + t; GATE[slot] = __uint_as_float(x[j]); }
                    SEL[(size_t)(tokbase + t) * NE + e] = sel ? slot : -1; }
                run_sel += tot2;
            } }
        __syncthreads();
    }
}

__device__ __forceinline__ void phase_gather(const Ctx& X, bool last) {
    const int gw = X.bid * NWAVE + X.wave, NGW = X.nb * NWAVE;
    const int* TOK = (const int*)(X.ws + O_TOK); const bf16* U = (const bf16*)(X.ws + O_U); bf16* XS = (bf16*)(X.ws + O_XS);
    for (int s = gw; s < MXR; s += 4 * NGW) {
        int r[4]; bool ok[4]; u32x4 a[4][2];
#pragma unroll
        for (int k = 0; k < 4; ++k) { const int sk = s + k * NGW; ok[k] = sk < MXR && !(last && (sk % ME) >= NB * CAPL); r[k] = ok[k] ? TOK[sk] : 0; }
#pragma unroll
        for (int k = 0; k < 4; ++k) { const u32x4* src = (const u32x4*)(U + (size_t)r[k] * D) + X.lane; a[k][0] = src[0]; a[k][1] = src[64]; }
#pragma unroll
        for (int k = 0; k < 4; ++k) if (ok[k]) { u32x4* dst = (u32x4*)(XS + (size_t)(s + k * NGW) * D) + X.lane; dst[0] = a[k][0]; dst[64] = a[k][1]; } }
}

constexpr int NPH = 14;
constexpr int GP_END = 1 + DEPTH * NPH + 1;

__global__ void __launch_bounds__(NTHR, 2) fwd_kernel(Args args) {
    extern __shared__ __attribute__((aligned(16))) unsigned char lds_raw[];
    Ctx X;
    X.out = args.out; X.ws = args.ws; X.lds = (LAS unsigned char*)lds_raw;
    X.tid = threadIdx.x; X.lane = X.tid & 63; X.wave = __builtin_amdgcn_readfirstlane(X.tid >> 6); X.bid = blockIdx.x; X.nb = gridDim.x;
    const int wave0 = X.wave;
    volatile LAS unsigned* misc = (volatile LAS unsigned*)(X.lds + LDS_MISC);
    if (X.tid < 64) misc[X.tid] = 0u;
    __syncthreads();
    const int lo = args.lo, hi = args.hi;
    if (hi - lo > 1) (void)xcd_barrier_post((unsigned*)(X.ws + O_CTL) + 4096, misc + 8);
    LAS unsigned char* glds = (LAS unsigned char*)X.lds;
#define RUN(gp) ((gp) >= lo && (gp) < hi)
#define FRESH() do { int wv_ = wave0; asm volatile("" : "+s"(wv_)); int t_ = wv_ * 64 + (int)__builtin_amdgcn_mbcnt_hi(~0u, __builtin_amdgcn_mbcnt_lo(~0u, 0u)); asm volatile("" : "+v"(t_)); X.tid = t_; X.lane = t_ & 63; X.wave = wv_; int nb_ = gridDim.x, bid_ = blockIdx.x; asm volatile("" : "+s"(nb_), "+s"(bid_)); X.nb = nb_; X.bid = bid_; unsigned long long w_ = (unsigned long long)args.ws; asm volatile("" : "+s"(w_)); X.ws = (unsigned char*)(__attribute__((address_space(1))) unsigned char*)w_;     lyr = layer; asm volatile("" : "+s"(lyr)); } while (0)
#define SEAM(gp) do { if ((gp) + 1 < hi) { XcdBarrier bb_; bb_.bar = (unsigned*)(X.ws + O_CTL) + 4096; bb_.x = xb_xcc_id(); bb_.st = (volatile LAS unsigned*)(X.lds + LDS_MISC) + 8; xcd_barrier(bb_); } } while (0)

    int lyr = 0; const int layer = 0;
    if (RUN(0)) { FRESH(); phase_prologue(X, args); SEAM(0); }
    for (int layer = 0; layer < DEPTH; ++layer) {
        const int g0 = 1 + layer * NPH;
        const bool last = (layer == DEPTH - 1); const int rows = last ? ML : MT;
        if (RUN(g0 + 0)) { FRESH(); phase_weights(X, args, lyr); phase_norm1<false>(X, args, lyr); SEAM(g0 + 0); }
        if (RUN(g0 + 1)) { FRESH();
            pg8::Gemm g{(const bf16*)(X.ws + O_U), (const bf16*)(X.ws + O_WIN), MT, NZ, D, D, D}; pg8::StaticOrder S; S.init(MT, NZ, X.nb, X.bid);
            EpiZ E{(bf16*)(X.ws + O_Z), (bf16*)(X.ws + O_FCT), (bf16*)(X.ws + O_FCTC), (unsigned char*)(X.ws + O_G8)};
            pg8::gemm_phase<EpiZ, pg8::StaticOrder>(glds, g, S, E, X.tid); SEAM(g0 + 1); }
        if (RUN(g0 + 2)) { FRESH(); phase_conv(X, args, lyr); FRESH();
            { pg8::Gemm g{(const bf16*)(X.ws + O_Z) + ZC_LIN, (const bf16*)(X.ws + O_LORA), MT, LN, LK, NZ, LK}; pg8::LoraOrder S;     S.init(MT, LN, X.nb, X.bid);
              EpiBf16Store E{(bf16*)(X.ws + O_LO), LN};
              pg8::gemm_phase<EpiBf16Store, pg8::LoraOrder>(glds, g, S, E, X.tid); }
            SEAM(g0 + 2); }
        if (RUN(g0 + 5)) { FRESH(); phase_scan(X, args, lyr); SEAM(g0 + 5); }
        if (RUN(g0 + 6)) { FRESH(); phase_post(X, args, lyr, rows); SEAM(g0 + 6); }
        if (RUN(g0 + 7)) { FRESH();
            pg8::Gemm g{(const bf16*)(X.ws + O_Y), (const bf16*)(X.ws + O_PT), MT, D, D, D, D}; pg8::Merge3Order S; S.init(rows, D, X.nb, X.bid);
            EpiMerge3 E{(bf16*)(X.ws + O_MX), (const unsigned char*)(X.ws + O_G8)};
            pg8::gemm_phase<EpiMerge3, pg8::Merge3Order>(glds, g, S, E, X.tid); SEAM(g0 + 7); }
        if (RUN(g0 + 8)) { FRESH();
            pg8::Gemm g{(const bf16*)(X.ws + O_MX), (const bf16*)(X.ws + O_WOT), MT, D, D, D, D}; pg8::StaticOrder S; S.init(rows, D, X.nb, X.bid);
            EpiResid E{(bf16*)(X.ws + O_H), (const float*)(X.ws + O_MOD) + (size_t)lyr * 9 * 6144};
            pg8::gemm_phase<EpiResid, pg8::StaticOrder>(glds, g, S, E, X.tid); SEAM(g0 + 8); }
        if (RUN(g0 + 9)) { FRESH(); phase_norm2(X, args, lyr, rows); SEAM(g0 + 9); }
        if (RUN(g0 + 10)) { FRESH(); phase_topk(X, last); SEAM(g0 + 10); }
        if (RUN(g0 + 11) && X.nb != 256) { FRESH(); phase_gather(X, last); SEAM(g0 + 11); }
        if (RUN(g0 + 12)) { FRESH();
            pg8::GroupOrder S; S.init(NE, last ? NB * CAPL / 256 : ME / 256, 16, X.nb, X.bid, ME / 256);
            EpiHid E{(bf16*)(X.ws + O_HID)};
            if (X.nb == 256) { pg8::Gemm g{(const bf16*)(X.ws + O_U), (const bf16*)(X.ws + O_W13), MXR, NE * 4096, D, D, D};
                pg8::gemm_phase<EpiHid, pg8::GroupOrder, true>(glds, g, S, E, X.tid, (const int*)(X.ws + O_TOK)); }
            else { pg8::Gemm g{(const bf16*)(X.ws + O_XS), (const bf16*)(X.ws + O_W13), MXR, NE * 4096, D, D, D};
                pg8::gemm_phase<EpiHid, pg8::GroupOrder, false>(glds, g, S, E, X.tid); }
            SEAM(g0 + 12); }
        if (RUN(g0 + 13)) { FRESH();
            pg8::Gemm g{(const bf16*)(X.ws + O_HID), (const bf16*)(X.ws + O_W2T), MXR, NE * D, EH, EH, EH}; pg8::GroupOrder S; S.init(NE, last ? NB * CAPL / 256 : ME / 256, 4, X.nb, X.bid, ME / 256);
            EpiExpertOut E{(bf16*)(X.ws + O_XS), (const float*)(X.ws + O_GATE)};
            pg8::gemm_phase<EpiExpertOut, pg8::GroupOrder>(glds, g, S, E, X.tid); SEAM(g0 + 13); }
    }
    if (RUN(GP_END - 1)) { const int layer = DEPTH; FRESH(); phase_norm1<true>(X, args, lyr); }
#undef RUN
#undef SEAM
}

extern "C" void kernel_launch(void* const* d_in, const int* in_sizes, int n_in, void* d_out, int out_size, void* d_ws, size_t ws_size, hipStream_t stream) {
    static int grid = 0;
    if (grid == 0) {
        if (n_in != 32 || in_sizes[0] != ML * D || out_size != ML * D || ws_size < WS_END) {
            fprintf(stderr, "kernel_launch: unexpected shapes (n_in %d, in0 %d, out %d, ws %zu, need %zu); nothing launched\n", n_in, n_in > 0 ? in_sizes[0] : -1, out_size, ws_size, (size_t)WS_END); grid = -1; return; }
        int dev = 0, cus = 0, per_cu = 0;
        if (hipGetDevice(&dev) != hipSuccess || hipDeviceGetAttribute(&cus, hipDeviceAttributeMultiprocessorCount, dev) != hipSuccess) { grid = -1; return; }
        if (hipFuncSetAttribute((const void*)fwd_kernel, hipFuncAttributeMaxDynamicSharedMemorySize, LDS_BYTES) != hipSuccess) { fprintf(stderr, "kernel_launch: hipFuncSetAttribute failed\n"); grid = -1; return; }
        if (hipOccupancyMaxActiveBlocksPerMultiprocessor(&per_cu, (const void*)fwd_kernel, NTHR, LDS_BYTES) != hipSuccess || per_cu < 1) { fprintf(stderr, "kernel_launch: occupancy query says %d\n", per_cu); }
        (void)hipGetLastError();
        grid = cus;
    }
    if (grid < 0) return;
    (void)hipMemsetAsync((char*)d_ws + O_CTL, 0, SZ_CTL, stream);
    Args a{};
    for (int i = 0; i < 32; ++i) a.in[i] = (const float*)d_in[i];
    a.out = (float*)d_out; a.ws = (unsigned char*)d_ws;
#if N_LAUNCH_MODE == 1
    a.lo = 0; a.hi = GP_END;
    hipLaunchKernelGGL(fwd_kernel, dim3(grid), dim3(NTHR), LDS_BYTES, stream, a);
#else
    for (int gp = 0; gp < GP_END; ++gp) { a.lo = gp; a.hi = gp + 1; hipLaunchKernelGGL(fwd_kernel, dim3(grid), dim3(NTHR), LDS_BYTES, stream, a); }
#endif
}
```
